# Optimizing an MI355X kernel written in HIP

```python
import math
import jax, jax.numpy as jnp
from jax import lax
import numpy as np


D_MODEL = 2048
BATCH = 1
SEQ = 8192
DEPTH = 1

CTX_LEN = 256
GRID_W = 64
HEAD_DIM = 128
ROPE_PAIRS = HEAD_DIM // 4
ROPE_THETA = 10000.0
A_HEADS = 8
A_KV_HEADS = 2
A_GROUP = A_HEADS // A_KV_HEADS
B_HEADS = 4
B_V_DIM = 2 * HEAD_DIM
N_EXPERTS = 64
TOP_K = 8
N_GROUPS = 8
TOPK_GROUPS = 4
EXPERT_DIM = 512
SHARED_DIM = 512
ROUTED_SCALE = 2.5
EXPERT_BLOCK = 128
Q_BLOCK = 128
N_MOD = 6
EPS = 1e-6

A_Q_W = A_HEADS * HEAD_DIM
A_KV_W = A_KV_HEADS * HEAD_DIM
B_QK_W = B_HEADS * 2 * HEAD_DIM
B_V_W = B_HEADS * B_V_DIM
IN_SIZES = (A_Q_W, A_KV_W, A_KV_W, B_QK_W, B_QK_W, B_V_W, D_MODEL, D_MODEL)
IN_W = sum(IN_SIZES)
IN_OFFSETS = tuple(sum(IN_SIZES[:j + 1]) for j in range(len(IN_SIZES) - 1))

kernel_name = 'hybrid_gated_gqa_diffattn_moe_dit'


def rms_norm(x, g):
    xf = x.astype(jnp.float32)
    y = xf * lax.rsqrt(jnp.mean(xf * xf, axis=-1, keepdims=True) + EPS)
    return (y * g.astype(jnp.float32)).astype(x.dtype)


def adaln(cvec, w, b):
    m = jax.nn.silu(cvec) @ w + b
    return m.reshape(cvec.shape[0], N_MOD, 1, D_MODEL)


def modulate(h, shift, scale):
    return h * (1 + scale) + shift


def rope_tables(rows_n):
    rows = jnp.repeat(jnp.arange(rows_n, dtype=jnp.float32), GRID_W)
    cols = jnp.tile(jnp.arange(GRID_W, dtype=jnp.float32), rows_n)
    inv = ROPE_THETA ** (-jnp.arange(ROPE_PAIRS, dtype=jnp.float32) / ROPE_PAIRS)
    ang_r = rows[:, None] * inv
    ang_c = cols[:, None] * inv
    return (jnp.cos(ang_r)[:, None, :], jnp.sin(ang_r)[:, None, :],
            jnp.cos(ang_c)[:, None, :], jnp.sin(ang_c)[:, None, :])


def _rotate(u, cos, sin):
    u1, u2 = jnp.split(u, 2, axis=-1)
    return jnp.concatenate([u1 * cos - u2 * sin, u1 * sin + u2 * cos], axis=-1)


def apply_rope(x, tables):
    cr, sr, cc, sc = (t.astype(x.dtype) for t in tables)
    half = HEAD_DIM // 2
    return jnp.concatenate([_rotate(x[..., :half], cr, sr),
                            _rotate(x[..., half:], cc, sc)], axis=-1)


def project_heads(h, w_in, qn_a, kn_a, qn_b, kn_b, tables):
    b_, t_, _ = h.shape
    aq, ak, av, bq, bk, bv, ga, gb = jnp.split(h @ w_in, IN_OFFSETS, axis=-1)
    aq = rms_norm(aq.reshape(b_, t_, A_HEADS, HEAD_DIM), qn_a)
    ak = rms_norm(ak.reshape(b_, t_, A_KV_HEADS, HEAD_DIM), kn_a)
    bq = rms_norm(bq.reshape(b_, t_, 2 * B_HEADS, HEAD_DIM), qn_b)
    bk = rms_norm(bk.reshape(b_, t_, 2 * B_HEADS, HEAD_DIM), kn_b)
    if tables is not None:
        aq = apply_rope(aq, tables)
        ak = apply_rope(ak, tables)
        bq = apply_rope(bq, tables)
        bk = apply_rope(bk, tables)
    aq = aq.reshape(b_, t_, A_KV_HEADS, A_GROUP, HEAD_DIM)
    av = av.reshape(b_, t_, A_KV_HEADS, HEAD_DIM)
    bq = bq.reshape(b_, t_, B_HEADS, 2, HEAD_DIM)
    bk = bk.reshape(b_, t_, B_HEADS, 2, HEAD_DIM)
    bv = bv.reshape(b_, t_, B_HEADS, B_V_DIM)
    return aq, ak, av, bq, bk, bv, ga, gb


def gqa_core(q, k, v):
    s = jnp.einsum('bqkgd,bskd->bkgqs', q, k, preferred_element_type=jnp.float32)
    p = jax.nn.softmax(s * (HEAD_DIM ** -0.5), axis=-1)
    return jnp.einsum('bkgqs,bskd->bqkgd', p.astype(v.dtype), v)


def diff_core(q, k, v, lam):
    s = jnp.einsum('bqhmd,bshmd->bhmqs', q, k, preferred_element_type=jnp.float32)
    p = jax.nn.softmax(s * (HEAD_DIM ** -0.5), axis=-1)
    a = p[:, :, 0] - lam * p[:, :, 1]
    return jnp.einsum('bhqs,bshe->bqhe', a.astype(v.dtype), v)


def _to_blocks(a):
    b_, t_ = a.shape[:2]
    a = a.reshape((b_, t_ // Q_BLOCK, Q_BLOCK) + a.shape[2:])
    return jnp.moveaxis(a, 1, 0)


def _from_blocks(a):
    a = jnp.moveaxis(a, 0, 1)
    return a.reshape((a.shape[0], a.shape[1] * a.shape[2]) + a.shape[3:])


def sweep_latent(core, q):
    return _from_blocks(lax.map(core, _to_blocks(q)))


def merge_branches(oa, ob, ga, gb, subln_g, lam_init, wa, wb, wo):
    b_, t_ = oa.shape[:2]
    oa = oa.reshape(b_, t_, A_Q_W)
    ob = (rms_norm(ob, subln_g) * (1.0 - lam_init)).reshape(b_, t_, B_V_W)
    y = jax.nn.sigmoid(ga) * (oa @ wa) + jax.nn.sigmoid(gb) * (ob @ wb)
    return y @ wo


def swiglu(x, wg, wu, wd):
    return (jax.nn.silu(x @ wg) * (x @ wu)) @ wd


def routed_experts(hf, idx, wsel, weg, weu, wed):
    n = hf.shape[0]
    n_assign = n * TOP_K
    flat_e = idx.reshape(-1)
    order = jnp.argsort(flat_e, stable=True)
    sorted_e = flat_e[order]
    sorted_tok = (order // TOP_K).astype(jnp.int32)
    sorted_w = wsel.reshape(-1)[order]
    counts = jnp.bincount(flat_e, length=N_EXPERTS)
    padded = (counts + EXPERT_BLOCK - 1) // EXPERT_BLOCK * EXPERT_BLOCK
    pad_end = jnp.cumsum(padded)
    pad_start = pad_end - padded
    start = jnp.cumsum(counts) - counts
    dest = pad_start[sorted_e] + (jnp.arange(n_assign) - start[sorted_e])
    n_blocks = -(-n_assign // EXPERT_BLOCK) + N_EXPERTS
    total = n_blocks * EXPERT_BLOCK
    tok_buf = jnp.zeros((total,), jnp.int32).at[dest].set(sorted_tok)
    w_buf = jnp.zeros((total,), hf.dtype).at[dest].set(sorted_w)
    block_e = jnp.minimum(
        jnp.searchsorted(pad_end, jnp.arange(n_blocks) * EXPERT_BLOCK, side='right'),
        N_EXPERTS - 1)

    def step(out, blk):
        tok, wt, e = blk
        y = swiglu(hf[tok], weg[e], weu[e], wed[e]) * wt[:, None]
        return out.at[tok].add(y), None

    out, _ = lax.scan(step, jnp.zeros_like(hf),
                      (tok_buf.reshape(n_blocks, EXPERT_BLOCK),
                       w_buf.reshape(n_blocks, EXPERT_BLOCK), block_e))
    return out


def moe(h, w_router, router_bias, weg, weu, wed, wsg, wsu, wsd):
    shape = h.shape
    hf = h.reshape(-1, D_MODEL)
    n = hf.shape[0]
    scores = jax.nn.sigmoid((hf @ w_router).astype(jnp.float32))
    biased = scores + router_bias.astype(jnp.float32)
    per_group = N_EXPERTS // N_GROUPS
    grp_score = lax.top_k(biased.reshape(n, N_GROUPS, per_group), 2)[0].sum(-1)
    _, top_groups = lax.top_k(grp_score, TOPK_GROUPS)
    group_mask = jax.nn.one_hot(top_groups, N_GROUPS, dtype=jnp.float32).sum(1) > 0
    expert_mask = jnp.repeat(group_mask, per_group, axis=1)
    _, idx = lax.top_k(jnp.where(expert_mask, biased, -jnp.inf), TOP_K)
    wsel = jnp.take_along_axis(scores, idx, axis=1)
    wsel = wsel / jnp.sum(wsel, axis=-1, keepdims=True) * ROUTED_SCALE
    routed = routed_experts(hf, idx, wsel.astype(hf.dtype), weg, weu, wed)
    return (routed + swiglu(hf, wsg, wsu, wsd)).reshape(shape)


def setup_inputs(seed: int = 0) -> dict:
    key = jax.random.key(seed)
    ks = jax.random.split(key, 29)
    f32 = jnp.float32

    def nrm(k, shape, scale):
        return jax.random.normal(k, shape, f32) * scale

    def gain(k, shape):
        return 1.0 + 0.02 * jax.random.normal(k, shape, f32)

    D, E, F, FS = D_MODEL, N_EXPERTS, EXPERT_DIM, SHARED_DIM
    return {
        'x': nrm(ks[0], (BATCH, SEQ, D), 1.0),
        'c': nrm(ks[1], (BATCH, D), 1.0),
        'ctx': nrm(ks[2], (BATCH, CTX_LEN, D), 1.0),
        'c_ctx': nrm(ks[3], (D,), 1.0),
        'w_ada': nrm(ks[4], (DEPTH, D, N_MOD * D), 0.5 * D ** -0.5),
        'b_ada': nrm(ks[5], (DEPTH, N_MOD * D), 0.02),
        'norm_mix': gain(ks[6], (DEPTH, D)),
        'norm_ffn': gain(ks[7], (DEPTH, D)),
        'w_in': nrm(ks[8], (DEPTH, D, IN_W), D ** -0.5),
        'q_norm_a': gain(ks[9], (DEPTH, HEAD_DIM)),
        'k_norm_a': gain(ks[10], (DEPTH, HEAD_DIM)),
        'q_norm_b': gain(ks[11], (DEPTH, HEAD_DIM)),
        'k_norm_b': gain(ks[12], (DEPTH, HEAD_DIM)),
        'lambda_q1': nrm(ks[13], (DEPTH, HEAD_DIM), 0.1),
        'lambda_k1': nrm(ks[14], (DEPTH, HEAD_DIM), 0.1),
        'lambda_q2': nrm(ks[15], (DEPTH, HEAD_DIM), 0.1),
        'lambda_k2': nrm(ks[16], (DEPTH, HEAD_DIM), 0.1),
        'subln_b': gain(ks[17], (DEPTH, B_V_DIM)),
        'w_branch_a': nrm(ks[18], (DEPTH, A_Q_W, D), A_Q_W ** -0.5),
        'w_branch_b': nrm(ks[19], (DEPTH, B_V_W, D), B_V_W ** -0.5),
        'w_out': nrm(ks[20], (DEPTH, D, D), D ** -0.5),
        'w_router': nrm(ks[21], (DEPTH, D, E), D ** -0.5),
        'router_bias': nrm(ks[22], (DEPTH, E), 0.01),
        'w_exp_gate': nrm(ks[23], (DEPTH, E, D, F), D ** -0.5),
        'w_exp_up': nrm(ks[24], (DEPTH, E, D, F), D ** -0.5),
        'w_exp_down': nrm(ks[25], (DEPTH, E, F, D), F ** -0.5),
        'w_sh_gate': nrm(ks[26], (DEPTH, D, FS), D ** -0.5),
        'w_sh_up': nrm(ks[27], (DEPTH, D, FS), D ** -0.5),
        'w_sh_down': nrm(ks[28], (DEPTH, FS, D), FS ** -0.5),
    }


def reference(x, c, ctx, c_ctx, w_ada, b_ada, norm_mix, norm_ffn, w_in,
              q_norm_a, k_norm_a, q_norm_b, k_norm_b,
              lambda_q1, lambda_k1, lambda_q2, lambda_k2, subln_b,
              w_branch_a, w_branch_b, w_out, w_router, router_bias,
              w_exp_gate, w_exp_up, w_exp_down, w_sh_gate, w_sh_up, w_sh_down):
    ROWS = x.shape[1] // GRID_W
    tables = rope_tables(ROWS)
    f32 = jnp.float32
    for i in range(DEPTH):
        last = i == DEPTH - 1
        lam_init = 0.8 - 0.6 * math.exp(-0.3 * i)
        lam = (jnp.exp(jnp.sum(lambda_q1[i].astype(f32) * lambda_k1[i].astype(f32)))
               - jnp.exp(jnp.sum(lambda_q2[i].astype(f32) * lambda_k2[i].astype(f32)))
               + lam_init)
        mod = adaln(c, w_ada[i], b_ada[i])
        mod_c = adaln(c_ctx[None, :], w_ada[i], b_ada[i])

        h = modulate(rms_norm(x, norm_mix[i]), mod[:, 0], mod[:, 1])
        hc = modulate(rms_norm(ctx, norm_mix[i]), mod_c[:, 0], mod_c[:, 1])
        aq, ak, av, bq, bk, bv, ga, gb = project_heads(
            h, w_in[i], q_norm_a[i], k_norm_a[i], q_norm_b[i], k_norm_b[i], tables)
        caq, cak, cav, cbq, cbk, cbv, cga, cgb = project_heads(
            hc, w_in[i], q_norm_a[i], k_norm_a[i], q_norm_b[i], k_norm_b[i], None)
        ak_all = jnp.concatenate([cak, ak], axis=1)
        av_all = jnp.concatenate([cav, av], axis=1)
        bk_all = jnp.concatenate([cbk, bk], axis=1)
        bv_all = jnp.concatenate([cbv, bv], axis=1)
        oa = sweep_latent(lambda qb: gqa_core(qb, ak_all, av_all), aq)
        ob = sweep_latent(lambda qb: diff_core(qb, bk_all, bv_all, lam), bq)
        y = merge_branches(oa, ob, ga, gb, subln_b[i], lam_init,
                           w_branch_a[i], w_branch_b[i], w_out[i])
        x = x + mod[:, 2] * y

        if not last:
            oac = gqa_core(caq, cak, cav)
            obc = diff_core(cbq, cbk, cbv, lam)
            yc = merge_branches(oac, obc, cga, cgb, subln_b[i], lam_init,
                                w_branch_a[i], w_branch_b[i], w_out[i])
            ctx = ctx + mod_c[:, 2] * yc
            hc2 = modulate(rms_norm(ctx, norm_ffn[i]), mod_c[:, 3], mod_c[:, 4])
            ctx = ctx + mod_c[:, 5] * moe(hc2, w_router[i], router_bias[i],
                                          w_exp_gate[i], w_exp_up[i], w_exp_down[i],
                                          w_sh_gate[i], w_sh_up[i], w_sh_down[i])

        h2 = modulate(rms_norm(x, norm_ffn[i]), mod[:, 3], mod[:, 4])
        x = x + mod[:, 5] * moe(h2, w_router[i], router_bias[i],
                                w_exp_gate[i], w_exp_up[i], w_exp_down[i],
                                w_sh_gate[i], w_sh_up[i], w_sh_down[i])
    return x
```

```cpp
#include <hip/hip_runtime.h>
#include <hip/hip_bf16.h>
#include <cstdio>
#include <cstdint>

#ifndef MK_ONE_LAUNCH
#define MK_ONE_LAUNCH 1
#endif

#define GAS __attribute__((address_space(1)))
#define LAS __attribute__((address_space(3)))
typedef unsigned short bf16_t;
typedef short bf16x8 __attribute__((ext_vector_type(8)));
typedef float f32x4 __attribute__((ext_vector_type(4)));
typedef float f32x2 __attribute__((ext_vector_type(2)));
typedef float f32x16 __attribute__((ext_vector_type(16)));
typedef unsigned u32x4 __attribute__((ext_vector_type(4)));
typedef unsigned u32x2 __attribute__((ext_vector_type(2)));
typedef short s16x4 __attribute__((ext_vector_type(4)));

constexpr int DM = 2048, SEQ = 8192, CTXL = 256, MT = SEQ + CTXL;
constexpr int INW = 8704;
constexpr int C_AQ = 0, C_AK = 1024, C_AV = 1280, C_BQ = 1536, C_BK = 2560, C_BV = 3584, C_GA = 4608, C_GB = 6656;
constexpr int NE = 64, TOPK = 8, FE = 512, NMOD = 6;
constexpr int SH_TILE0 = 320;
constexpr int MOE_ROWS = (SH_TILE0 + 32) * 256;
constexpr float EPS = 1e-6f;
constexpr int NWAVES = 8, NTHREADS = 512;

constexpr size_t MiB = 1u << 20;
constexpr size_t WS_CTL = 0, CTL_ZERO_BYTES = 1 * MiB;
constexpr size_t WS_MODP = 1 * MiB;
constexpr size_t WS_MOD = WS_MODP + 512 * 1024;
constexpr size_t WS_TOKE = 2 * MiB, WS_TOKS = WS_TOKE + 256 * 1024, WS_TOKW = WS_TOKS + 256 * 1024;
constexpr size_t WS_LIST = 3 * MiB;
constexpr size_t WS_WRHI = 5 * MiB, WS_WRLO = WS_WRHI + 256 * 1024;
constexpr size_t WS_WIN = 8 * MiB;
constexpr size_t WS_WA = 42 * MiB, WS_WB = 46 * MiB, WS_WO = 50 * MiB;
constexpr size_t WS_WGU = 58 * MiB;
constexpr size_t WS_WD = 318 * MiB;
constexpr size_t WS_X1 = 448 * MiB;
constexpr size_t WS_ACT = 512 * MiB;
constexpr size_t WS_OVER = 600 * MiB;
constexpr size_t WS_YROWS = WS_OVER;
constexpr size_t WS_H = WS_OVER;
constexpr size_t WS_Y = WS_OVER;
constexpr size_t WS_P = WS_OVER + 34 * MiB;
constexpr size_t WS_H2HI = WS_P, WS_H2LO = WS_P + 32 * MiB;
constexpr size_t WS_OA = WS_OVER + 176 * MiB, WS_OB0 = WS_OA + 32 * MiB, WS_OB1 = WS_OB0 + 32 * MiB;
constexpr size_t WS_Y1 = WS_OA;
constexpr size_t WS_A2 = WS_OVER + 272 * MiB;
constexpr size_t WS_END = WS_OVER + 352 * MiB;
static_assert(WS_P + (size_t)MT * INW * 2 <= WS_OA && WS_A2 + 32 * MiB <= WS_END && WS_H + (size_t)MT * DM * 2 <= WS_P, "ws map");
static_assert(WS_WGU + (size_t)65 * 1024 * 2048 * 2 <= WS_WD && WS_WD + (size_t)65 * 2048 * 512 * 2 <= WS_X1, "ws map 2");
constexpr int CW_TMO = 0;
constexpr int CW_ADA = 2048;
constexpr int CW_CNT = 1024;
constexpr int CW_BAR = 4096;

constexpr int RING_BYTES = 131072;
constexpr int LDSCTL_OFF = RING_BYTES, MISC_OFF = LDSCTL_OFF + 320, TAB_OFF = LDSCTL_OFF + 1024;
constexpr int LDS_BYTES = 147456;

#define RLX_AGENT __ATOMIC_RELAXED, __HIP_MEMORY_SCOPE_AGENT
#define LDS_WAIT() asm volatile("s_waitcnt lgkmcnt(0)" ::: "memory")
#define VM_WAIT() asm volatile("s_waitcnt vmcnt(0)" ::: "memory")
__device__ __forceinline__ unsigned f2bf(float f) { unsigned u = __builtin_bit_cast(unsigned, f); return (u + 0x7fffu + ((u >> 16) & 1u)) >> 16; }
__device__ __forceinline__ unsigned pk2(float lo, float hi) { return f2bf(lo) | (f2bf(hi) << 16); }
__device__ __forceinline__ float bf2f(unsigned short b) { return __uint_as_float((unsigned)b << 16); }
__device__ __forceinline__ float bflo(unsigned w) { return __uint_as_float(w << 16); }
__device__ __forceinline__ float bfhi(unsigned w) { return __uint_as_float(w & 0xffff0000u); }
__device__ __forceinline__ unsigned cvt_pk_bf16(float lo, float hi) { unsigned r; asm volatile("v_cvt_pk_bf16_f32 %0, %1, %2" : "=v"(r) : "v"(lo), "v"(hi)); return r; }
__device__ __forceinline__ float sigmoidf_(float x) { return __builtin_amdgcn_rcpf(1.0f + __expf(-x)); }
__device__ __forceinline__ float wave_sum(float v) {
#pragma unroll
    for (int o = 1; o < 64; o <<= 1) v += __shfl_xor(v, o);
    return v;
}

#define XB_TMO      128
#define XB_XCNT(j)  (256  + 64 * (j))
#define XB_XSUB(j)  (1280 + 64 * (j))
#define XB_XGEN(j)  (2304 + 64 * (j))
#define XB_TOP      3328
#define XB_TOPGEN   3392
#define XCD_BAR_WORDS 3456
#define XB_SPIN_CAP (1u << 18)
__device__ __forceinline__ unsigned xb_ld(unsigned* p)              { return __hip_atomic_load(p, __ATOMIC_RELAXED, __HIP_MEMORY_SCOPE_AGENT); }
__device__ __forceinline__ unsigned xb_add(unsigned* p, unsigned v) { return __hip_atomic_fetch_add(p, v, __ATOMIC_RELAXED, __HIP_MEMORY_SCOPE_AGENT); }
__device__ __forceinline__ unsigned xb_xcc_id() { return (unsigned)__builtin_amdgcn_s_getreg((3 << 11) | 20) & 0xFu; }
#define XB_SPIN(cond, bar) do { unsigned _sp = 0; while (cond) { __builtin_amdgcn_s_sleep(1); \
    if ((++_sp & 255u) == 0u) { if (xb_ld(&(bar)[XB_TMO])) break; if (_sp > XB_SPIN_CAP) { atomicAdd(&(bar)[XB_TMO], 1u); break; } } } } while (0)
struct XcdBarrier { unsigned* bar; unsigned x; volatile LAS unsigned* st; };
__device__ __forceinline__ XcdBarrier xcd_barrier_post(unsigned* bar, volatile LAS unsigned* st) {
    XcdBarrier b; b.bar = bar; b.x = xb_xcc_id(); b.st = st;
    if (threadIdx.x == 0) (void)xb_add(&bar[XB_XCNT(b.x)], 1u);
    return b;
}
__device__ __forceinline__ void xcd_barrier_complete(unsigned* bar, unsigned x, unsigned& nloc, unsigned& nx) {
    const unsigned G = gridDim.x * gridDim.y * gridDim.z;
    unsigned sum, cnt, mine, sp = 0u;
    for (;;) {
        sum = 0u; cnt = 0u; mine = 0u;
#pragma unroll
        for (unsigned j = 0; j < 16; ++j) { const unsigned c = xb_ld(&bar[XB_XCNT(j)]); sum += c; cnt += (c > 0u) ? 1u : 0u; mine = (j == x) ? c : mine; }
        if (sum == G) break;
        __builtin_amdgcn_s_sleep(1);
        if ((++sp & 255u) == 0u) { if (xb_ld(&bar[XB_TMO])) break; if (sp > XB_SPIN_CAP) { atomicAdd(&bar[XB_TMO], 1u); break; } }
    }
    nloc = mine > 0u ? mine : 1u; nx = cnt > 0u ? cnt : 1u;
}
__device__ __forceinline__ void xcd_barrier(const XcdBarrier& b) {
    asm volatile("s_waitcnt vmcnt(0)" ::: "memory");
    __syncthreads();
    if (threadIdx.x == 0) {
        unsigned* bar = b.bar;
        __builtin_amdgcn_s_waitcnt(0);
        unsigned nloc = b.st[0], nx = b.st[1];
        if (nloc == 0u) { xcd_barrier_complete(bar, b.x, nloc, nx); b.st[0] = nloc; b.st[1] = nx; }
        const unsigned old = xb_add(&bar[XB_XSUB(b.x)], 1u);
        const unsigned gen = old / nloc;
        if (old + 1u == (gen + 1u) * nloc) {
            __builtin_amdgcn_fence(__ATOMIC_RELEASE, "agent");
            asm volatile("s_waitcnt vmcnt(0)" ::: "memory");
            const unsigned og = xb_add(&bar[XB_TOP], 1u);
            const unsigned tg = og / nx;
            if (og + 1u == (tg + 1u) * nx) xb_add(&bar[XB_TOPGEN], 1u);
            else XB_SPIN(xb_ld(&bar[XB_TOPGEN]) == tg, bar);
            __builtin_amdgcn_fence(__ATOMIC_ACQUIRE, "agent");
            xb_add(&bar[XB_XGEN(b.x)], 1u);
            asm volatile("s_waitcnt vmcnt(0)" ::: "memory");
        } else {
            XB_SPIN(xb_ld(&bar[XB_XGEN(b.x)]) == gen, bar);
            __builtin_amdgcn_fence(__ATOMIC_ACQUIRE, "agent");
            asm volatile("s_waitcnt vmcnt(0)" ::: "memory");
        }
    }
    __syncthreads();
}

namespace pg8 {
constexpr int BM = 256, BK = 64, HALF = 128, HTB = HALF * BK * 2, STAGE_BYTES = 8 * HTB;
__host__ __device__ __forceinline__ int lds_byte(int r, int c) { const int st = (r >> 4) * 2 + (c >> 5), rr = r & 15, cc = c & 31, ob = rr * 64 + cc * 2; return st * 1024 + (ob ^ (((ob >> 9) & 1) << 5)); }
__host__ __device__ __forceinline__ void stage_rc(int b, int& R, int& C) { const int st = b / 1024, sb = b % 1024, swz = sb ^ (((sb >> 9) & 1) << 5); R = (st >> 1) * 16 + swz / 64; C = (st & 1) * 32 + (swz % 64) / 2; }
__host__ __device__ __forceinline__ int perm32(int rho) { const int n = rho >> 4, i = rho & 15; return 8 * (i >> 2) + 4 * n + (i & 3); }

struct Unit { int pm, pn, pb, e, mt, cnt; };
struct Gemm { const bf16_t* A; const bf16_t* Bt; int lda, ldb, K; };

struct StaticOrder {
    int nM, nN, nwg, G, c;
    __device__ void init(int M, int N, int G_, int c_) { nM = M / BM; nN = N / BM; nwg = nM * nN; G = G_; c = c_; }
    __device__ __forceinline__ bool next(int i, Unit& u) const {
        const long L = (long)i * G + c; if (L >= nwg) return false;
        int wgid = (int)L; { const int q = nwg / 8, r = nwg % 8, xcd = wgid % 8, off = wgid / 8; wgid = (xcd < r ? xcd * (q + 1) : r * (q + 1) + (xcd - r) * q) + off; }
        const int nig = 8 * nN, gid = wgid / nig, fm = gid * 8, gsz = (nM - fm) < 8 ? (nM - fm) : 8;
        u.pm = fm + ((wgid % nig) % gsz); u.pn = (wgid % nig) / gsz; u.pb = u.pn; u.e = 0; u.mt = 0; u.cnt = 0; return true;
    }
    __device__ __forceinline__ int arow(const Unit& u, int r) const { return u.pm * BM + r; }
};
struct MoeOrder {
    const LAS int* cnt; const LAS int* toff; const int* list; int G, c, nN, total; bool gather;
    __device__ __forceinline__ bool next(int i, Unit& u) const {
        const int L = i * G + c; if (L >= total) return false;
        const int rt = L / nN, nt = L % nN;
        int e = 0;
#pragma unroll
        for (int j = 64; j >= 1; j >>= 1) { const int t = e + j; if (t <= 64 && toff[t] <= rt) e = t; }
        e = __builtin_amdgcn_readfirstlane(e);
        const int mt = rt - __builtin_amdgcn_readfirstlane(toff[e]);
        u.e = e; u.mt = mt; u.cnt = __builtin_amdgcn_readfirstlane(cnt[e]);
        u.pm = (e < 64) ? rt : SH_TILE0 + mt; u.pn = nt; u.pb = e * nN + nt; return true;
    }
    __device__ __forceinline__ int arow(const Unit& u, int r) const {
        if (!gather) return u.pm * BM + r;
        const int s = u.mt * BM + r;
        if (u.e == 64) return s;
        return s < u.cnt ? list[u.e * SEQ + s] : 0;
    }
};

#define EPI_LOOP_BEGIN const int row0_ = u.pm * BM + wr * 64 + fr; const int colL_ = wc * 32 + 8 * fq; \
    _Pragma("unroll") for (int ai = 0; ai < 2; ++ai) _Pragma("unroll") for (int m = 0; m < 4; ++m) { const int row = row0_ + ai * HALF + m * 16;
#define EPI_LOOP_END }

struct EpiBf16 {
    bf16_t* O; int ldc;
    __device__ __forceinline__ void operator()(const f32x4 (&acc)[2][2][4][2], const Unit& u, int wr, int wc, int fr, int fq) const {
        EPI_LOOP_BEGIN
            bf16_t* rowp = O + (size_t)row * ldc + u.pn * BM + colL_;
#pragma unroll
            for (int bj = 0; bj < 2; ++bj) { const f32x4 v0 = acc[ai][bj][m][0], v1 = acc[ai][bj][m][1];
                u32x4 w; w.x = cvt_pk_bf16(v0[0], v0[1]); w.y = cvt_pk_bf16(v0[2], v0[3]); w.z = cvt_pk_bf16(v1[0], v1[1]); w.w = cvt_pk_bf16(v1[2], v1[3]);
                *(u32x4*)(rowp + bj * HALF) = w; }
        EPI_LOOP_END
    }
};
struct EpiGateF32 {
    float* O; int ldc; const bf16_t* Gt; int ldg; int grow0, gcol0;
    __device__ __forceinline__ void operator()(const f32x4 (&acc)[2][2][4][2], const Unit& u, int wr, int wc, int fr, int fq) const {
        EPI_LOOP_BEGIN
            float* rowp = O + (size_t)row * ldc + u.pn * BM + colL_;
            const bf16_t* gp = Gt + (size_t)(row + grow0) * ldg + gcol0 + u.pn * BM + colL_;
#pragma unroll
            for (int bj = 0; bj < 2; ++bj) { const u32x4 g = *(const u32x4*)(gp + bj * HALF); const f32x4 v0 = acc[ai][bj][m][0], v1 = acc[ai][bj][m][1];
                f32x4 o0, o1;
                o0[0] = v0[0] * sigmoidf_(bflo(g.x)); o0[1] = v0[1] * sigmoidf_(bfhi(g.x)); o0[2] = v0[2] * sigmoidf_(bflo(g.y)); o0[3] = v0[3] * sigmoidf_(bfhi(g.y));
                o1[0] = v1[0] * sigmoidf_(bflo(g.z)); o1[1] = v1[1] * sigmoidf_(bfhi(g.z)); o1[2] = v1[2] * sigmoidf_(bflo(g.w)); o1[3] = v1[3] * sigmoidf_(bfhi(g.w));
                *(f32x4*)(rowp + bj * HALF) = o0; *(f32x4*)(rowp + bj * HALF + 4) = o1; }
        EPI_LOOP_END
    }
};
struct EpiGateAddBf16 {
    bf16_t* O; int ldc; const float* Y1; const bf16_t* Gt; int ldg; int grow0, gcol0;
    __device__ __forceinline__ void operator()(const f32x4 (&acc)[2][2][4][2], const Unit& u, int wr, int wc, int fr, int fq) const {
        EPI_LOOP_BEGIN
            const size_t co = (size_t)row * ldc + u.pn * BM + colL_;
            const bf16_t* gp = Gt + (size_t)(row + grow0) * ldg + gcol0 + u.pn * BM + colL_;
#pragma unroll
            for (int bj = 0; bj < 2; ++bj) { const u32x4 g = *(const u32x4*)(gp + bj * HALF); const f32x4 v0 = acc[ai][bj][m][0], v1 = acc[ai][bj][m][1];
                const f32x4 y0 = *(const f32x4*)(Y1 + co + bj * HALF), y1 = *(const f32x4*)(Y1 + co + bj * HALF + 4);
                f32x4 o0, o1;
                o0[0] = y0[0] + v0[0] * sigmoidf_(bflo(g.x)); o0[1] = y0[1] + v0[1] * sigmoidf_(bfhi(g.x)); o0[2] = y0[2] + v0[2] * sigmoidf_(bflo(g.y)); o0[3] = y0[3] + v0[3] * sigmoidf_(bfhi(g.y));
                o1[0] = y1[0] + v1[0] * sigmoidf_(bflo(g.z)); o1[1] = y1[1] + v1[1] * sigmoidf_(bfhi(g.z)); o1[2] = y1[2] + v1[2] * sigmoidf_(bflo(g.w)); o1[3] = y1[3] + v1[3] * sigmoidf_(bfhi(g.w));
                u32x4 w; w.x = cvt_pk_bf16(o0[0], o0[1]); w.y = cvt_pk_bf16(o0[2], o0[3]); w.z = cvt_pk_bf16(o1[0], o1[1]); w.w = cvt_pk_bf16(o1[2], o1[3]);
                *(u32x4*)(O + co + bj * HALF) = w; }
        EPI_LOOP_END
    }
};
struct EpiResidF32 {
    float* O; const float* X; int ldc; const float* gate;
    __device__ __forceinline__ void operator()(const f32x4 (&acc)[2][2][4][2], const Unit& u, int wr, int wc, int fr, int fq) const {
        const int colL0 = u.pn * BM + wc * 32 + 8 * fq;
        f32x4 gv[2][2];
#pragma unroll
        for (int bj = 0; bj < 2; ++bj)
#pragma unroll
            for (int n = 0; n < 2; ++n) gv[bj][n] = *(const f32x4*)(gate + colL0 + bj * HALF + 4 * n);
        EPI_LOOP_BEGIN
            const size_t co = (size_t)row * ldc + u.pn * BM + colL_;
#pragma unroll
            for (int bj = 0; bj < 2; ++bj)
#pragma unroll
                for (int n = 0; n < 2; ++n) { const f32x4 x = *(const f32x4*)(X + co + bj * HALF + 4 * n);
                    *(f32x4*)(O + co + bj * HALF + 4 * n) = x + gv[bj][n] * acc[ai][bj][m][n]; }
        EPI_LOOP_END
    }
};
struct EpiSwiglu {
    bf16_t* O; int ldc;
    __device__ __forceinline__ void operator()(const f32x4 (&acc)[2][2][4][2], const Unit& u, int wr, int wc, int fr, int fq) const {
        EPI_LOOP_BEGIN
            bf16_t* rowp = O + (size_t)row * ldc + u.pn * HALF + colL_;
            f32x4 o[2];
#pragma unroll
            for (int n = 0; n < 2; ++n) { const f32x4 g = acc[ai][0][m][n], up = acc[ai][1][m][n];
#pragma unroll
                for (int j = 0; j < 4; ++j) o[n][j] = g[j] * sigmoidf_(g[j]) * up[j]; }
            u32x4 w; w.x = cvt_pk_bf16(o[0][0], o[0][1]); w.y = cvt_pk_bf16(o[0][2], o[0][3]); w.z = cvt_pk_bf16(o[1][0], o[1][1]); w.w = cvt_pk_bf16(o[1][2], o[1][3]);
            *(u32x4*)rowp = w;
        EPI_LOOP_END
    }
};

template <class Epi, class Sched, bool ALIGN_EPI>
__device__ __forceinline__ void gemm_phase(LAS unsigned char* lds, const Gemm g, const Sched& S, const Epi& E) {
    int tid = threadIdx.x; asm volatile("" : "+v"(tid));
    const int wid = __builtin_amdgcn_readfirstlane(tid >> 6), lane = tid & 63, wr = wid >> 2, wc = wid & 3, fr = lane & 15, fq = lane >> 4;
    const int K = g.K, nt = K / BK, lda = g.lda, ldb = g.ldb;
    int Rr[2], Cc[2]; unsigned voffB[2];
#pragma unroll
    for (int i = 0; i < 2; ++i) { int R, C; stage_rc(tid * 16 + i * 8192, R, C); Rr[i] = R; Cc[i] = C; const int Rb = (R & ~31) + perm32(R & 31);
        voffB[i] = (unsigned)(Rb * ldb + C) * 2u; }
    const size_t kstep = (size_t)(BK * 2);
    const size_t hstepB = (size_t)HALF * ldb * 2, tstepB = 2 * hstepB;
    const unsigned ldsw = (unsigned)wid * 1024u;
    const int aoff = lds_byte(wr * 64 + fr, fq * 8), boff = lds_byte(wc * 32 + fr, fq * 8);
#define PG8_SA(b, h) (((b) * 2 + (h)) * HTB)
#define PG8_SB(b, h) ((4 + (b) * 2 + (h)) * HTB)
#define PG8_STAGE2(bufoff, gbase, v0, v1) do { \
        __builtin_amdgcn_global_load_lds((const unsigned*)((const char*)(gbase) + (v0)), (LAS unsigned*)(lds + (bufoff) + ldsw), 16, 0, 0); \
        __builtin_amdgcn_global_load_lds((const unsigned*)((const char*)(gbase) + (v1)), (LAS unsigned*)(lds + (bufoff) + ldsw + 8192), 16, 0, 0); } while (0)
#define PG8_STAGEB(bufoff, gbase) PG8_STAGE2(bufoff, gbase, voffB[0], voffB[1])
#define PG8_LDA(dst, b, h) do { _Pragma("unroll") for (int m = 0; m < 4; ++m) _Pragma("unroll") for (int k = 0; k < 2; ++k) dst[m][k] = *(const LAS bf16x8*)(lds + PG8_SA(b, h) + aoff + m * 2048 + k * 1024); } while (0)
#define PG8_LDB(dst, b, h) do { _Pragma("unroll") for (int n = 0; n < 2; ++n) _Pragma("unroll") for (int k = 0; k < 2; ++k) dst[n][k] = *(const LAS bf16x8*)(lds + PG8_SB(b, h) + boff + n * 2048 + k * 1024); } while (0)
#define PG8_MMA(ai, bj, At, Bt) do { __builtin_amdgcn_s_setprio(1); _Pragma("unroll") for (int m = 0; m < 4; ++m) _Pragma("unroll") for (int n = 0; n < 2; ++n) _Pragma("unroll") for (int k = 0; k < 2; ++k) \
        acc[ai][bj][m][n] = __builtin_amdgcn_mfma_f32_16x16x32_bf16(Bt[n][k], At[m][k], acc[ai][bj][m][n], 0, 0, 0); __builtin_amdgcn_s_setprio(0); } while (0)
#define PG8_WAIT_V(n) asm volatile("s_waitcnt vmcnt(" #n ")" ::: "memory")
#define PG8_WAIT_L(n) asm volatile("s_waitcnt lgkmcnt(" #n ")" ::: "memory")
#define PG8_BAR __builtin_amdgcn_s_barrier()
#define PG8_SCHED __builtin_amdgcn_sched_barrier(0)
#define PG8_SETAO(dst, uu) do { _Pragma("unroll") for (int h_ = 0; h_ < 2; ++h_) _Pragma("unroll") for (int i_ = 0; i_ < 2; ++i_) \
        dst[h_][i_] = (unsigned)(S.arow(uu, h_ * HALF + Rr[i_]) * lda + Cc[i_]) * 2u; } while (0)
    Unit cur, nxt; int ui = 0;
    if (!S.next(0, cur)) return;
    f32x4 acc[2][2][4][2];
#pragma unroll
    for (int a = 0; a < 2; ++a)
#pragma unroll
        for (int b = 0; b < 2; ++b)
#pragma unroll
            for (int m = 0; m < 4; ++m)
#pragma unroll
                for (int n = 0; n < 2; ++n) acc[a][b][m][n] = (f32x4){0.f, 0.f, 0.f, 0.f};
    bf16x8 At[4][2], B0[2][2], B1[2][2];
    unsigned aoC[2][2], aoN[2][2];
    PG8_SETAO(aoC, cur);
    const char* gA = (const char*)g.A;
    const char* cB = (const char*)g.Bt + (size_t)cur.pb * tstepB;
    PG8_STAGEB(PG8_SB(0, 0), cB); PG8_STAGEB(PG8_SB(0, 1), cB + hstepB); PG8_STAGE2(PG8_SA(0, 0), gA, aoC[0][0], aoC[0][1]); PG8_STAGE2(PG8_SA(0, 1), gA, aoC[1][0], aoC[1][1]);
    if (wr == 1) PG8_BAR;
    PG8_WAIT_V(2); PG8_BAR;
    PG8_STAGEB(PG8_SB(1, 0), cB + kstep); PG8_STAGE2(PG8_SA(1, 0), gA + kstep, aoC[0][0], aoC[0][1]); PG8_STAGEB(PG8_SB(1, 1), cB + hstepB + kstep);
    PG8_WAIT_V(6); PG8_BAR;
    for (;;) {
        const bool has_next = S.next(ui + 1, nxt);
        if (has_next) { PG8_SETAO(aoN, nxt); }
        else {
#pragma unroll
            for (int h_ = 0; h_ < 2; ++h_)
#pragma unroll
                for (int i_ = 0; i_ < 2; ++i_) aoN[h_][i_] = aoC[h_][i_];
        }
        const char* nB = has_next ? (const char*)g.Bt + (size_t)nxt.pb * tstepB : cB;
        for (int t = 0; t < nt; t += 2) {
            const bool last = (t == nt - 2);
            const char* a1 = gA + (size_t)(t + 1) * kstep;
            const char* a2 = last ? gA : gA + (size_t)(t + 2) * kstep; const char* b2 = last ? nB : cB + (size_t)(t + 2) * kstep;
            const char* a3 = a2 + kstep; const char* b3 = b2 + kstep;
            const unsigned x00 = last ? aoN[0][0] : aoC[0][0], x01 = last ? aoN[0][1] : aoC[0][1], x10 = last ? aoN[1][0] : aoC[1][0], x11 = last ? aoN[1][1] : aoC[1][1];
            PG8_LDB(B0, 0, 0); PG8_LDB(B1, 0, 1); PG8_SCHED; PG8_LDA(At, 0, 0); PG8_STAGE2(PG8_SA(1, 1), a1, aoC[1][0], aoC[1][1]);
            PG8_WAIT_V(8); PG8_WAIT_L(0); PG8_BAR; PG8_MMA(0, 0, At, B0); PG8_MMA(0, 1, At, B1); PG8_BAR; PG8_SCHED;
            PG8_LDA(At, 0, 1); PG8_STAGEB(PG8_SB(0, 0), b2); PG8_STAGEB(PG8_SB(0, 1), b2 + hstepB); PG8_STAGE2(PG8_SA(0, 0), a2, x00, x01);
            PG8_WAIT_V(8); PG8_WAIT_L(0); PG8_BAR; PG8_MMA(1, 0, At, B0); PG8_MMA(1, 1, At, B1); PG8_BAR; PG8_SCHED;
            PG8_LDB(B0, 1, 0); PG8_LDB(B1, 1, 1); PG8_SCHED; PG8_LDA(At, 1, 0); PG8_STAGE2(PG8_SA(0, 1), a2, x10, x11);
            PG8_WAIT_V(8); PG8_WAIT_L(0); PG8_BAR; PG8_MMA(0, 0, At, B0); PG8_MMA(0, 1, At, B1); PG8_BAR; PG8_SCHED;
            PG8_LDA(At, 1, 1); PG8_STAGEB(PG8_SB(1, 0), b3); PG8_STAGEB(PG8_SB(1, 1), b3 + hstepB); PG8_STAGE2(PG8_SA(1, 0), a3, x00, x01);
            PG8_WAIT_V(8); PG8_WAIT_L(0); PG8_BAR; PG8_MMA(1, 0, At, B0); PG8_MMA(1, 1, At, B1); PG8_BAR; PG8_SCHED;
        }
        if constexpr (ALIGN_EPI) { if (wr == 0) PG8_BAR; }
        E(acc, cur, wr, wc, fr, fq);
        if (!has_next) break;
#pragma unroll
        for (int a = 0; a < 2; ++a)
#pragma unroll
            for (int b = 0; b < 2; ++b)
#pragma unroll
                for (int m = 0; m < 4; ++m)
#pragma unroll
                    for (int n = 0; n < 2; ++n) acc[a][b][m][n] = (f32x4){0.f, 0.f, 0.f, 0.f};
        cur = nxt; cB = nB; ++ui;
#pragma unroll
        for (int h_ = 0; h_ < 2; ++h_)
#pragma unroll
            for (int i_ = 0; i_ < 2; ++i_) aoC[h_][i_] = aoN[h_][i_];
        if constexpr (ALIGN_EPI) { if (wr == 1) PG8_BAR; }
    }
    PG8_WAIT_V(0);
    if constexpr (!ALIGN_EPI) { if (wr == 0) PG8_BAR; }
    PG8_BAR;
#undef PG8_SA
#undef PG8_SB
#undef PG8_STAGE2
#undef PG8_STAGEB
#undef PG8_LDA
#undef PG8_LDB
#undef PG8_MMA
#undef PG8_WAIT_V
#undef PG8_WAIT_L
#undef PG8_BAR
#undef PG8_SCHED
#undef PG8_SETAO
}
}

namespace attn {
using bf16 = __hip_bfloat16;
constexpr int D = 128, NW = 8, QBLK = 32, KVBLK = 64;
constexpr float SCALE = 0.088388347648318440f;
constexpr float THR = 8.f;
constexpr int LDQ = INW, LDK = INW, LDO = 1024;
constexpr size_t SHM_V = KVBLK * D * 2, SHM_K = KVBLK * D * 2, SHM_ATTN = 2 * SHM_V + 2 * SHM_K + NW * 64 * 4;
#define KSWZ(row, colB) ((row) * 256 + ((colB) ^ (((row) & 7) << 4)))
#define SBAR() __builtin_amdgcn_sched_barrier(0)
__device__ __forceinline__ int crow(int r, int hi) { return (r & 3) + 8 * (r >> 2) + 4 * hi; }
__device__ __forceinline__ unsigned cvtpk(float lo, float hi) { unsigned r; asm volatile("v_cvt_pk_bf16_f32 %0, %1, %2" : "=v"(r) : "v"(lo), "v"(hi)); return r; }
__device__ __forceinline__ bf16x8 ld8(const bf16* p) { return *reinterpret_cast<const bf16x8*>(p); }

__device__ __forceinline__ void partialSM(f32x16& p0, f32x16& p1, float& m_reg, float& mn, float& alpha) {
  constexpr float C = SCALE * 1.4426950408889634f;
  float pmax = p0[0];
#pragma unroll
  for (int r = 1; r < 16; ++r) pmax = fmaxf(pmax, p0[r]);
#pragma unroll
  for (int r = 0; r < 16; ++r) pmax = fmaxf(pmax, p1[r]);
  { auto rr = __builtin_amdgcn_permlane32_swap(__float_as_uint(pmax), __float_as_uint(pmax), false, false);
    pmax = fmaxf(__uint_as_float(rr[0]), __uint_as_float(rr[1])); }
  if (__builtin_expect(__all(pmax - m_reg <= THR / SCALE), 1)) { mn = m_reg; alpha = 1.f; }
  else { mn = fmaxf(m_reg, pmax); alpha = __builtin_amdgcn_exp2f((m_reg - mn) * C); m_reg = mn; }
  float mnC = -mn * C;
#pragma unroll
  for (int r = 0; r < 16; ++r) p0[r] = fmaf(p0[r], C, mnC);
#pragma unroll
  for (int r = 0; r < 16; ++r) p1[r] = fmaf(p1[r], C, mnC);
#pragma unroll
  for (int r = 0; r < 16; ++r) p0[r] = __builtin_amdgcn_exp2f(p0[r]);
}
__device__ __forceinline__ void finishSM(f32x16& p0, f32x16& p1, float alpha, float& l_reg, bf16x8& pa0, bf16x8& pa1, bf16x8& pa2, bf16x8& pa3) {
#pragma unroll
  for (int r = 0; r < 16; ++r) p1[r] = __builtin_amdgcn_exp2f(p1[r]);
  float ps = 0;
#pragma unroll
  for (int r = 0; r < 16; ++r) ps += p0[r];
#pragma unroll
  for (int r = 0; r < 16; ++r) ps += p1[r];
  { auto rr = __builtin_amdgcn_permlane32_swap(__float_as_uint(ps), __float_as_uint(ps), false, false);
    ps = __uint_as_float(rr[0]) + __uint_as_float(rr[1]); }
  l_reg = l_reg * alpha + ps;
#define PK4(P, BASE, OUT) do { unsigned a0 = cvtpk(P[BASE + 0], P[BASE + 1]), a1 = cvtpk(P[BASE + 2], P[BASE + 3]);   \
    unsigned b0 = cvtpk(P[BASE + 4], P[BASE + 5]), b1 = cvtpk(P[BASE + 6], P[BASE + 7]);                              \
    auto r0 = __builtin_amdgcn_permlane32_swap(a0, b0, false, false); auto r1 = __builtin_amdgcn_permlane32_swap(a1, b1, false, false); \
    u32x4 w = {r0[0], r1[0], r0[1], r1[1]}; OUT = *reinterpret_cast<bf16x8*>(&w); } while (0)
  PK4(p0, 0, pa0); PK4(p0, 8, pa1); PK4(p1, 0, pa2); PK4(p1, 8, pa3);
#undef PK4
}
__device__ __forceinline__ void qkt(f32x16& p0, f32x16& p1, const bf16* Ks, const bf16x8* qr, int r32, int hi) {
  p0 = f32x16{}; p1 = f32x16{};
#pragma unroll
  for (int d0 = 0; d0 < 8; ++d0) { int cb = (d0 * 16 + hi * 8) * 2;
    bf16x8 b0 = *reinterpret_cast<const bf16x8*>((const char*)Ks + KSWZ(r32, cb));
    bf16x8 b1 = *reinterpret_cast<const bf16x8*>((const char*)Ks + KSWZ(32 + r32, cb));
    p0 = __builtin_amdgcn_mfma_f32_32x32x16_bf16(b0, qr[d0], p0, 0, 0, 0);
    p1 = __builtin_amdgcn_mfma_f32_32x32x16_bf16(b1, qr[d0], p1, 0, 0, 0); }
}
__device__ __forceinline__ int v_st(int k, int c) { const int kk = (k & ~0xC) | ((k & 4) << 1) | ((k & 8) >> 1); return ((kk >> 3) * 4 + (c >> 5)) * 512 + ((kk & 7) * 32 + (c & 31)) * 2; }
__device__ __forceinline__ int v_rd_base(int lane) { return ((lane & 3) << 3) | (((lane >> 2) & 3) << 6) | (((lane >> 4) & 1) << 5) | (((lane >> 5) & 1) << 8); }
constexpr int v_rd_off(int d0, int ks, int half) { return d0 * 512 + ks * 4096 + half * 2048; }
template <int OFF> __device__ __forceinline__ s16x4 tr_read(int vb) {
  s16x4 r; asm volatile("ds_read_b64_tr_b16 %0, %1 offset:%2" : "=&v"(r) : "v"(vb), "i"(OFF) : "memory"); return r;
}
template <int D0> __device__ __forceinline__ void pv_one(f32x16& od, int vb, bf16x8 pa0, bf16x8 pa1, bf16x8 pa2, bf16x8 pa3) {
  const s16x4 l0 = tr_read<v_rd_off(D0, 0, 0)>(vb), h0 = tr_read<v_rd_off(D0, 0, 1)>(vb), l1 = tr_read<v_rd_off(D0, 1, 0)>(vb), h1 = tr_read<v_rd_off(D0, 1, 1)>(vb);
  const s16x4 l2 = tr_read<v_rd_off(D0, 2, 0)>(vb), h2 = tr_read<v_rd_off(D0, 2, 1)>(vb), l3 = tr_read<v_rd_off(D0, 3, 0)>(vb), h3 = tr_read<v_rd_off(D0, 3, 1)>(vb);
  asm volatile("s_waitcnt lgkmcnt(0)" ::: "memory"); SBAR();
#define PK(L, H) (bf16x8){L[0], L[1], L[2], L[3], H[0], H[1], H[2], H[3]}
  od = __builtin_amdgcn_mfma_f32_32x32x16_bf16(pa0, PK(l0, h0), od, 0, 0, 0);
  od = __builtin_amdgcn_mfma_f32_32x32x16_bf16(pa1, PK(l1, h1), od, 0, 0, 0);
  od = __builtin_amdgcn_mfma_f32_32x32x16_bf16(pa2, PK(l2, h2), od, 0, 0, 0);
  od = __builtin_amdgcn_mfma_f32_32x32x16_bf16(pa3, PK(l3, h3), od, 0, 0, 0);
#undef PK
}
__device__ __forceinline__ void pv_d0(f32x16* o, int vb, bf16x8 pa0, bf16x8 pa1, bf16x8 pa2, bf16x8 pa3) {
  pv_one<0>(o[0], vb, pa0, pa1, pa2, pa3); pv_one<1>(o[1], vb, pa0, pa1, pa2, pa3); pv_one<2>(o[2], vb, pa0, pa1, pa2, pa3); pv_one<3>(o[3], vb, pa0, pa1, pa2, pa3);
}
__device__ __forceinline__ void attn_dense_body(const bf16* __restrict__ Qb, const bf16* __restrict__ Kh, const bf16* __restrict__ Vh,
                                                float* __restrict__ Ob, int seq, char* lds) {
  int tid = threadIdx.x; asm volatile("" : "+v"(tid));
  const int wid = tid >> 6, lane = tid & 63, r32 = lane & 31, hi = lane >> 5;
  bf16* V_lds = (bf16*)lds; bf16* K_lds = (bf16*)(lds + 2 * SHM_V);
  float* ws = (float*)(lds + 2 * SHM_V + 2 * SHM_K) + wid * 64; float* li_l = ws; float* al_l = ws + 32;
  float m_reg = -1e30f, l_reg = 0; f32x16 o[4] = {}; bf16x8 qr[8];
  const bf16* Qw = Qb + (long)(wid * QBLK + r32) * LDQ + hi * 8;
#pragma unroll
  for (int d0 = 0; d0 < 8; ++d0) qr[d0] = ld8(Qw + d0 * 16);
  const int sr = tid >> 4, sc = (tid & 15) * 8, vst0 = v_st(sr, sc), vst1 = v_st(32 + sr, sc);
  const int vb0 = (int)(uintptr_t)V_lds + v_rd_base(lane);
  struct { bf16x8 vs0, vs1, ks0, ks1; } sr_[2];
#define SLOAD(i, k0) do { sr_[i].vs0 = ld8(&Vh[(long)((k0) + sr) * LDK + sc]); sr_[i].vs1 = ld8(&Vh[(long)((k0) + 32 + sr) * LDK + sc]); \
    sr_[i].ks0 = ld8(&Kh[(long)((k0) + sr) * LDK + sc]); sr_[i].ks1 = ld8(&Kh[(long)((k0) + 32 + sr) * LDK + sc]); } while (0)
#define SWRITE(b, i) do { *(bf16x8*)((char*)V_lds + (b) * SHM_V + vst0) = sr_[i].vs0;          \
    *(bf16x8*)((char*)V_lds + (b) * SHM_V + vst1) = sr_[i].vs1; int kc = sc * 2;               \
    *(bf16x8*)((char*)K_lds + (b) * SHM_K + KSWZ(sr, kc)) = sr_[i].ks0;                       \
    *(bf16x8*)((char*)K_lds + (b) * SHM_K + KSWZ(32 + sr, kc)) = sr_[i].ks1; } while (0)
#define SWAIT() asm volatile("s_waitcnt vmcnt(4)" ::: "memory")
#define RESC(a) do { if (__any((a) < 1.f)) { if (hi == 0) al_l[r32] = (a); asm volatile("s_waitcnt lgkmcnt(0)" ::: "memory"); \
    _Pragma("unroll") for (int d = 0; d < 4; ++d) _Pragma("unroll") for (int r = 0; r < 16; ++r) o[d][r] *= al_l[crow(r, hi)]; } } while (0)
  f32x16 pA0, pA1, pB0, pB1; float mnA, mnB, alA, alB; bf16x8 pa0, pa1, pa2, pa3; const int NT = seq / KVBLK;
  constexpr int SE = 0, SO = 1;
  SLOAD(SE, 0); asm volatile("s_waitcnt vmcnt(0)" ::: "memory"); SWRITE(0, SE); __syncthreads();
  qkt(pA0, pA1, K_lds, qr, r32, hi); partialSM(pA0, pA1, m_reg, mnA, alA);
  SLOAD(SO, KVBLK); if (2 < NT) SLOAD(SE, 2 * KVBLK);
  SWAIT(); SWRITE(1, SO); __syncthreads();
  for (int j = 1; j + 1 < NT; j += 2) {
    SBAR(); qkt(pB0, pB1, (bf16*)((char*)K_lds + SHM_K), qr, r32, hi);
    finishSM(pA0, pA1, alA, l_reg, pa0, pa1, pa2, pa3); SBAR();
    SLOAD(SO, (j + 2) * KVBLK); SBAR();
    pv_d0(o, vb0, pa0, pa1, pa2, pa3); partialSM(pB0, pB1, m_reg, mnB, alB);
    __syncthreads(); SWAIT(); SWRITE(0, SE);
    RESC(alB); __syncthreads();
    SBAR(); qkt(pA0, pA1, K_lds, qr, r32, hi);
    finishSM(pB0, pB1, alB, l_reg, pa0, pa1, pa2, pa3); SBAR();
    if (j + 3 < NT) SLOAD(SE, (j + 3) * KVBLK); SBAR();
    pv_d0(o, vb0 + (int)SHM_V, pa0, pa1, pa2, pa3); partialSM(pA0, pA1, m_reg, mnA, alA);
    __syncthreads(); SWAIT(); SWRITE(1, SO);
    RESC(alA); __syncthreads();
  }
  SBAR(); qkt(pB0, pB1, (bf16*)((char*)K_lds + SHM_K), qr, r32, hi);
  finishSM(pA0, pA1, alA, l_reg, pa0, pa1, pa2, pa3); SBAR();
  pv_d0(o, vb0, pa0, pa1, pa2, pa3); partialSM(pB0, pB1, m_reg, mnB, alB);
  __syncthreads(); RESC(alB);
  finishSM(pB0, pB1, alB, l_reg, pa0, pa1, pa2, pa3); SBAR();
  pv_d0(o, vb0 + (int)SHM_V, pa0, pa1, pa2, pa3);
  if (hi == 0) li_l[r32] = l_reg; asm volatile("s_waitcnt lgkmcnt(0)" ::: "memory");
  float rli[16];
#pragma unroll
  for (int r = 0; r < 16; ++r) rli[r] = __builtin_amdgcn_rcpf(li_l[crow(r, hi)]);
  float* Ow = Ob + (long)(wid * QBLK) * LDO;
#pragma unroll
  for (int r = 0; r < 16; ++r) { int orow = crow(r, hi);
#pragma unroll
    for (int d0 = 0; d0 < 4; ++d0) Ow[(long)orow * LDO + d0 * 32 + r32] = o[d0][r] * rli[r]; }
  __syncthreads();
#undef SLOAD
#undef SWRITE
#undef SWAIT
#undef RESC
}
#undef SBAR
}

struct Args { const float* in[29]; float* out; unsigned char* ws; int ph_lo, ph_hi, one_launch, pad; };
typedef const __attribute__((address_space(4))) Args* KArgs;
struct Frame {
    LAS unsigned char* lds;
    volatile LAS unsigned* MISC;
    unsigned* ctl;
    int tid, lane, wave, vcu, G;
    KArgs ap;
    float* out; unsigned char* ws;
};
#define INP(i) (F.ap->in[i])
#define RELAUNDER() asm volatile("" : "+s"(F.ap))
enum { I_X = 0, I_C, I_CTX, I_CCTX, I_WADA, I_BADA, I_NMIX, I_NFFN, I_WIN, I_QNA, I_KNA, I_QNB, I_KNB, I_LQ1, I_LK1, I_LQ2, I_LK2, I_SUBLN, I_WA, I_WB, I_WO, I_WR, I_RB, I_WEG, I_WEU, I_WED, I_WSG, I_WSU, I_WSD };

__device__ __forceinline__ f32x4 load_mod4(const Frame& F, int v, int j, int k) {
    return *(const f32x4*)((const float*)(F.ws + WS_MOD) + (size_t)v * (NMOD * DM) + j * DM + k);
}

__device__ __forceinline__ void transpose_item(const float* W, int ldw, int k0, int n0, bf16_t* dst0, int ldt, LAS float* scr, int lane) {
#pragma unroll 8
    for (int i = 0; i < 32; ++i) { const int kk = 2 * i + (lane >> 5); scr[kk * 33 + (lane & 31)] = W[(size_t)(k0 + kk) * ldw + n0 + (lane & 31)]; }
    LDS_WAIT(); asm volatile("" ::: "memory");
    const int c = lane & 7;
#pragma unroll
    for (int j = 0; j < 4; ++j) { const int n = (lane >> 3) + 8 * j; const LAS float* s = scr + (8 * c) * 33 + n;
        u32x4 o; o.x = pk2(s[0 * 33], s[1 * 33]); o.y = pk2(s[2 * 33], s[3 * 33]); o.z = pk2(s[4 * 33], s[5 * 33]); o.w = pk2(s[6 * 33], s[7 * 33]);
        *(u32x4*)(dst0 + (size_t)n * ldt + 8 * c) = o; }
    LDS_WAIT(); asm volatile("" ::: "memory");
}

__device__ __forceinline__ void p0_prologue(Frame& F) {
    LAS float* scr = (LAS float*)(F.lds + F.wave * 16384);
    const int gw = F.vcu * NWAVES + F.wave, NGW = F.G * NWAVES;
    bf16_t* Win = (bf16_t*)(F.ws + WS_WIN); bf16_t* Wa = (bf16_t*)(F.ws + WS_WA); bf16_t* Wb = (bf16_t*)(F.ws + WS_WB); bf16_t* Wo = (bf16_t*)(F.ws + WS_WO);
    bf16_t* Wgu = (bf16_t*)(F.ws + WS_WGU); bf16_t* Wd = (bf16_t*)(F.ws + WS_WD);
    constexpr int I_IN = (DM / 64) * (INW / 32);
    constexpr int I_AB = (1024 / 64) * (DM / 32);
    constexpr int I_OO = (DM / 64) * (DM / 32);
    constexpr int I_G1 = (DM / 64) * (FE / 32);
    constexpr int I_D1 = (FE / 64) * (DM / 32);
    constexpr int NITEMS = I_IN + 2 * I_AB + I_OO + 65 * (2 * I_G1 + I_D1);
    for (int it = gw; it < NITEMS; it += NGW) {
        int r = it;
        if (r < I_IN) { const int nblk = INW / 32, kb = r / nblk, nb = r % nblk; transpose_item(INP(I_WIN), INW, 64 * kb, 32 * nb, Win + (size_t)(32 * nb) * DM + 64 * kb, DM, scr, F.lane); continue; } r -= I_IN;
        if (r < I_AB) { const int nblk = DM / 32, kb = r / nblk, nb = r % nblk; transpose_item(INP(I_WA), DM, 64 * kb, 32 * nb, Wa + (size_t)(32 * nb) * 1024 + 64 * kb, 1024, scr, F.lane); continue; } r -= I_AB;
        if (r < I_AB) { const int nblk = DM / 32, kb = r / nblk, nb = r % nblk; transpose_item(INP(I_WB), DM, 64 * kb, 32 * nb, Wb + (size_t)(32 * nb) * 1024 + 64 * kb, 1024, scr, F.lane); continue; } r -= I_AB;
        if (r < I_OO) { const int nblk = DM / 32, kb = r / nblk, nb = r % nblk; transpose_item(INP(I_WO), DM, 64 * kb, 32 * nb, Wo + (size_t)(32 * nb) * DM + 64 * kb, DM, scr, F.lane); continue; } r -= I_OO;
        const int e = r / (2 * I_G1 + I_D1); r -= e * (2 * I_G1 + I_D1);
        if (r < 2 * I_G1) {
            const int isup = r >= I_G1; if (isup) r -= I_G1;
            const int nblk = FE / 32, kb = r / nblk, nb = r % nblk, n0 = 32 * nb;
            const float* src = (e < 64) ? INP(isup ? I_WEU : I_WEG) + (size_t)e * DM * FE : INP(isup ? I_WSU : I_WSG);
            const int trow = (n0 >> 7) * 256 + isup * 128 + (n0 & 127);
            transpose_item(src, FE, 64 * kb, n0, Wgu + ((size_t)e * 1024 + trow) * DM + 64 * kb, DM, scr, F.lane);
        } else { r -= 2 * I_G1;
            const int nblk = DM / 32, kb = r / nblk, nb = r % nblk;
            const float* src = (e < 64) ? INP(I_WED) + (size_t)e * FE * DM : INP(I_WSD);
            transpose_item(src, DM, 64 * kb, 32 * nb, Wd + ((size_t)e * DM + 32 * nb) * FE + 64 * kb, FE, scr, F.lane);
        }
    }
    { bf16_t* whi = (bf16_t*)(F.ws + WS_WRHI); bf16_t* wlo = (bf16_t*)(F.ws + WS_WRLO);
      for (int idx = (F.vcu * NTHREADS + F.tid); idx < DM * NE; idx += F.G * NTHREADS) { const int k = idx >> 6, n = idx & 63;
          const float w = INP(I_WR)[idx]; const unsigned h = f2bf(w); const float rem = w - __uint_as_float(h << 16);
          whi[n * DM + k] = (bf16_t)h; wlo[n * DM + k] = (bf16_t)f2bf(rem); } }
    __syncthreads();
    if (blockIdx.x < 192) {
        const int cb = blockIdx.x % 48, kq = blockIdx.x / 48;
        const float* wada = INP(I_WADA) + cb * 256 + 4 * F.lane;
        const int kbase = kq * 512 + F.wave * 64;
        f32x4 a0 = {0.f, 0.f, 0.f, 0.f}, a1 = {0.f, 0.f, 0.f, 0.f};
#pragma unroll 8
        for (int j = 0; j < 64; ++j) { const int k = kbase + j;
            const float c0 = INP(I_C)[k], c1 = INP(I_CCTX)[k];
            const float s0 = c0 * sigmoidf_(c0), s1 = c1 * sigmoidf_(c1);
            const f32x4 w = *(const f32x4*)(wada + (size_t)k * (NMOD * DM));
            a0 = a0 + w * s0; a1 = a1 + w * s1; }
        LAS f32x4* red = (LAS f32x4*)F.lds;
        red[(F.wave * 2 + 0) * 64 + F.lane] = a0; red[(F.wave * 2 + 1) * 64 + F.lane] = a1;
        LDS_WAIT(); __syncthreads();
        { const int v = F.tid >> 8, col = F.tid & 255; const LAS float* rf = (const LAS float*)F.lds; float s = 0.f;
#pragma unroll
          for (int w = 0; w < 8; ++w) s += rf[((w * 2 + v) * 64 + (col >> 2)) * 4 + (col & 3)];
          float* modp = (float*)(F.ws + WS_MODP);
          modp[(size_t)(kq * 2 + v) * (NMOD * DM) + cb * 256 + col] = s; }
        __threadfence(); __syncthreads();
        LAS unsigned* flg = (LAS unsigned*)(F.lds + 32768);
        if (F.tid == 0) { const unsigned old = __hip_atomic_fetch_add(F.ctl + CW_ADA + cb, 1u, __ATOMIC_ACQ_REL, __HIP_MEMORY_SCOPE_AGENT); flg[0] = (old == 3u) ? 1u : 0u; }
        LDS_WAIT(); __syncthreads();
        if (flg[0]) { __threadfence();
            const int v = F.tid >> 8, col = cb * 256 + (F.tid & 255); const float* modp = (const float*)(F.ws + WS_MODP);
            float s = INP(I_BADA)[col];
#pragma unroll
            for (int q = 0; q < 4; ++q) s += __hip_atomic_load(modp + (size_t)(q * 2 + v) * (NMOD * DM) + col, __ATOMIC_RELAXED, __HIP_MEMORY_SCOPE_AGENT);
            ((float*)(F.ws + WS_MOD))[(size_t)v * (NMOD * DM) + col] = s; }
        __syncthreads();
    }
}

template <bool SPLIT>
__device__ __forceinline__ void norm_mod_rows(Frame& F, int nrows, const float* gain, int jshift, bf16_t* ohi, bf16_t* olo, bool ctx_first) {
    const int gw = F.vcu * NWAVES + F.wave, NGW = F.G * NWAVES;
    f32x4 Am[8], Bm[8]; int curv = -1;
    for (int r = gw; r < nrows; r += NGW) {
        const int v = (ctx_first && r < CTXL) ? 1 : 0;
        if (v != curv) { curv = v;
#pragma unroll
            for (int j = 0; j < 8; ++j) { const int k = 4 * F.lane + 256 * j; const f32x4 g = *(const f32x4*)(gain + k);
                const f32x4 sh = load_mod4(F, v, jshift, k), sc = load_mod4(F, v, jshift + 1, k);
                Am[j] = g * (sc + 1.0f); Bm[j] = sh; } }
        const float* src = ctx_first ? (r < CTXL ? INP(I_CTX) + (size_t)r * DM : INP(I_X) + (size_t)(r - CTXL) * DM) : (const float*)(F.ws + WS_X1) + (size_t)r * DM;
        f32x4 x[8]; float ss = 0.f;
#pragma unroll
        for (int j = 0; j < 8; ++j) { x[j] = *(const f32x4*)(src + 4 * F.lane + 256 * j); ss += (x[j][0] * x[j][0] + x[j][1] * x[j][1]) + (x[j][2] * x[j][2] + x[j][3] * x[j][3]); }
        const float rstd = 1.0f / sqrtf(wave_sum(ss) * (1.0f / DM) + EPS);
#pragma unroll
        for (int j = 0; j < 8; ++j) { const f32x4 h = (x[j] * rstd) * Am[j] + Bm[j];
            const unsigned w0 = pk2(h[0], h[1]), w1 = pk2(h[2], h[3]);
            u32x2 o; o.x = w0; o.y = w1; *(u32x2*)(ohi + (size_t)r * DM + 4 * F.lane + 256 * j) = o;
            if (SPLIT) { u32x2 l; l.x = pk2(h[0] - bflo(w0), h[1] - bfhi(w0)); l.y = pk2(h[2] - bflo(w1), h[3] - bfhi(w1)); *(u32x2*)(olo + (size_t)r * DM + 4 * F.lane + 256 * j) = l; } }
    }
}

__device__ __forceinline__ void p3_headnorm_rope(Frame& F) {
    const int gw = F.vcu * NWAVES + F.wave, NGW = F.G * NWAVES;
    bf16_t* P = (bf16_t*)(F.ws + WS_P);
    const int e0 = 2 * F.lane;
    const int i0 = e0 & 31;
    const float inv0 = exp2f(-(float)i0 * (13.287712379549449f / 32.0f)), inv1 = exp2f(-(float)(i0 + 1) * (13.287712379549449f / 32.0f));
    const bool second = (F.lane & 16) != 0;
    f32x2 gq_a = *(const f32x2*)(INP(I_QNA) + e0), gk_a = *(const f32x2*)(INP(I_KNA) + e0), gq_b = *(const f32x2*)(INP(I_QNB) + e0), gk_b = *(const f32x2*)(INP(I_KNB) + e0);
    for (int r = gw; r < MT; r += NGW) {
        const bool lat = r >= CTXL;
        float c0 = 1.f, s0 = 0.f, c1 = 1.f, s1 = 0.f;
        if (lat) { const int t = r - CTXL; const float pos = (F.lane < 32) ? (float)(t >> 6) : (float)(t & 63);
            const float a0 = pos * inv0, a1 = pos * inv1; c0 = cosf(a0); s0 = sinf(a0); c1 = cosf(a1); s1 = sinf(a1); }
        bf16_t* prow = P + (size_t)r * INW;
        for (int hh = 0; hh < 26; ++hh) {
            int col; f32x2 g;
            if (hh < 8) { if (!lat) continue; col = C_AQ + hh * 128; g = gq_a; }
            else if (hh < 10) { col = C_AK + (hh - 8) * 128; g = gk_a; }
            else if (hh < 18) { if (!lat) continue; col = C_BQ + (hh - 10) * 128; g = gq_b; }
            else { col = C_BK + (hh - 18) * 128; g = gk_b; }
            unsigned* pp = (unsigned*)(prow + col + e0);
            const unsigned w = *pp; float x0 = bflo(w), x1 = bfhi(w);
            const float ss = wave_sum(x0 * x0 + x1 * x1);
            const float rstd = 1.0f / sqrtf(ss * (1.0f / 128.0f) + EPS);
            x0 = x0 * rstd * g[0]; x1 = x1 * rstd * g[1];
            if (lat) { const float y0 = __shfl_xor(x0, 16), y1 = __shfl_xor(x1, 16);
                if (!second) { x0 = x0 * c0 - y0 * s0; x1 = x1 * c1 - y1 * s1; } else { x0 = y0 * s0 + x0 * c0; x1 = y1 * s1 + x1 * c1; } }
            *pp = pk2(x0, x1);
        }
    }
}

__device__ __forceinline__ void p5_combine(Frame& F) {
    const int gw = F.vcu * NWAVES + F.wave, NGW = F.G * NWAVES;
    float d1 = INP(I_LQ1)[F.lane] * INP(I_LK1)[F.lane] + INP(I_LQ1)[F.lane + 64] * INP(I_LK1)[F.lane + 64];
    float d2 = INP(I_LQ2)[F.lane] * INP(I_LK2)[F.lane] + INP(I_LQ2)[F.lane + 64] * INP(I_LK2)[F.lane + 64];
    d1 = wave_sum(d1); d2 = wave_sum(d2);
    const float lam_init = 0.2f;
    const float lam = expf(d1) - expf(d2) + lam_init;
    const float* OA = (const float*)(F.ws + WS_OA); const float* OB0 = (const float*)(F.ws + WS_OB0); const float* OB1 = (const float*)(F.ws + WS_OB1);
    bf16_t* A2 = (bf16_t*)(F.ws + WS_A2);
    const f32x4 sg = *(const f32x4*)(INP(I_SUBLN) + 4 * F.lane);
    for (int t = gw; t < SEQ; t += NGW) {
#pragma unroll
        for (int j = 0; j < 4; ++j) { const f32x4 a = *(const f32x4*)(OA + (size_t)t * 1024 + 4 * F.lane + 256 * j);
            u32x2 o; o.x = pk2(a[0], a[1]); o.y = pk2(a[2], a[3]); *(u32x2*)(A2 + (size_t)t * DM + 4 * F.lane + 256 * j) = o; }
#pragma unroll
        for (int h = 0; h < 4; ++h) { const f32x4 u0 = *(const f32x4*)(OB0 + (size_t)t * 1024 + h * 256 + 4 * F.lane), u1 = *(const f32x4*)(OB1 + (size_t)t * 1024 + h * 256 + 4 * F.lane);
            const f32x4 d = u0 - u1 * lam;
            const float ss = wave_sum((d[0] * d[0] + d[1] * d[1]) + (d[2] * d[2] + d[3] * d[3]));
            const float rstd = 1.0f / sqrtf(ss * (1.0f / 256.0f) + EPS);
            const f32x4 y = (d * rstd) * sg * (1.0f - lam_init);
            u32x2 o; o.x = pk2(y[0], y[1]); o.y = pk2(y[2], y[3]); *(u32x2*)(A2 + (size_t)t * DM + 1024 + h * 256 + 4 * F.lane) = o; }
    }
}

__device__ __forceinline__ void p10_router(Frame& F) {
    const bf16_t* Hhi = (const bf16_t*)(F.ws + WS_H2HI); const bf16_t* Hlo = (const bf16_t*)(F.ws + WS_H2LO);
    const bf16_t* Whi = (const bf16_t*)(F.ws + WS_WRHI); const bf16_t* Wlo = (const bf16_t*)(F.ws + WS_WRLO);
    int* tokE = (int*)(F.ws + WS_TOKE); int* tokS = (int*)(F.ws + WS_TOKS); float* tokW = (float*)(F.ws + WS_TOKW); int* list = (int*)(F.ws + WS_LIST);
    unsigned* cnt = F.ctl + CW_CNT;
    LAS float* part = (LAS float*)F.lds;
    LAS float* logit = (LAS float*)(F.lds + 65536);
    LAS float* score = (LAS float*)(F.lds + 65536 + 32 * 65 * 4);
    const int r32 = F.lane & 31, hi = F.lane >> 5;
    for (int u = F.vcu; u < SEQ / 32; u += F.G) {
        const int row0 = u * 32;
        f32x16 acc0 = {}, acc1 = {};
        const int kb = F.wave * 256 + hi * 8;
#pragma unroll 4
        for (int s = 0; s < 16; ++s) { const int k = kb + 16 * s;
            const bf16x8 ah = *(const bf16x8*)(Hhi + (size_t)(row0 + r32) * DM + k), al = *(const bf16x8*)(Hlo + (size_t)(row0 + r32) * DM + k);
            const bf16x8 b0h = *(const bf16x8*)(Whi + (size_t)r32 * DM + k), b0l = *(const bf16x8*)(Wlo + (size_t)r32 * DM + k);
            const bf16x8 b1h = *(const bf16x8*)(Whi + (size_t)(32 + r32) * DM + k), b1l = *(const bf16x8*)(Wlo + (size_t)(32 + r32) * DM + k);
            acc0 = __builtin_amdgcn_mfma_f32_32x32x16_bf16(al, b0h, acc0, 0, 0, 0); acc0 = __builtin_amdgcn_mfma_f32_32x32x16_bf16(ah, b0l, acc0, 0, 0, 0); acc0 = __builtin_amdgcn_mfma_f32_32x32x16_bf16(ah, b0h, acc0, 0, 0, 0);
            acc1 = __builtin_amdgcn_mfma_f32_32x32x16_bf16(al, b1h, acc1, 0, 0, 0); acc1 = __builtin_amdgcn_mfma_f32_32x32x16_bf16(ah, b1l, acc1, 0, 0, 0); acc1 = __builtin_amdgcn_mfma_f32_32x32x16_bf16(ah, b1h, acc1, 0, 0, 0); }
#pragma unroll
        for (int r = 0; r < 16; ++r) { const int row = attn::crow(r, hi); part[(F.wave * 32 + row) * 64 + r32] = acc0[r]; part[(F.wave * 32 + row) * 64 + 32 + r32] = acc1[r]; }
        LDS_WAIT(); __syncthreads();
        { const int row = F.tid >> 4, e4 = (F.tid & 15) * 4; f32x4 s = {0.f, 0.f, 0.f, 0.f};
#pragma unroll
          for (int w = 0; w < 8; ++w) s = s + *(const LAS f32x4*)(part + (w * 32 + row) * 64 + e4);
#pragma unroll
          for (int j = 0; j < 4; ++j) { const float sc = sigmoidf_(s[j]); score[row * 65 + e4 + j] = sc; logit[row * 65 + e4 + j] = sc + INP(I_RB)[e4 + j]; } }
        LDS_WAIT(); __syncthreads();
        if (F.tid < 32) {
            const int row = F.tid, t = row0 + row; LAS float* bs = logit + row * 65; const LAS float* sc = score + row * 65;
            float gs[8];
#pragma unroll
            for (int g = 0; g < 8; ++g) { float m1 = -INFINITY, m2 = -INFINITY;
#pragma unroll
                for (int j = 0; j < 8; ++j) { const float v = bs[g * 8 + j]; if (v > m1) { m2 = m1; m1 = v; } else if (v > m2) m2 = v; }
                gs[g] = m1 + m2; }
            unsigned gmask = 0u;
#pragma unroll
            for (int it = 0; it < 4; ++it) { float bv = -INFINITY; int best = 0;
#pragma unroll
                for (int g = 0; g < 8; ++g) { const bool ok = !((gmask >> g) & 1u) && gs[g] > bv; bv = ok ? gs[g] : bv; best = ok ? g : best; }
                gmask |= 1u << best; }
            int ek[8]; float sk[8]; float ssum = 0.f;
#pragma unroll
            for (int it = 0; it < 8; ++it) { float bv = -INFINITY; int bi = 0;
                for (int e = 0; e < 64; ++e) { const float v = bs[e]; const bool ok = ((gmask >> (e >> 3)) & 1u) && v > bv; bv = ok ? v : bv; bi = ok ? e : bi; }
                ek[it] = bi; sk[it] = sc[bi]; ssum += sk[it]; bs[bi] = -INFINITY; }
            const float inv = 2.5f / ssum;
#pragma unroll
            for (int it = 0; it < 8; ++it) { const int e = ek[it];
                const unsigned slot = __hip_atomic_fetch_add(cnt + e, 1u, RLX_AGENT);
                list[e * SEQ + (int)slot] = t; tokE[t * 8 + it] = e; tokS[t * 8 + it] = (int)slot; tokW[t * 8 + it] = sk[it] * inv; }
        }
        __syncthreads();
    }
}

__device__ __forceinline__ void moe_tables(Frame& F) {
    LAS int* tab = (LAS int*)(F.lds + TAB_OFF);
    __syncthreads();
    if (F.tid == 0) { int off = 0;
        for (int e = 0; e < 64; ++e) { int c = (int)__hip_atomic_load(F.ctl + CW_CNT + e, RLX_AGENT); c = c < 0 ? 0 : (c > SEQ ? SEQ : c); tab[e] = c; tab[65 + e] = off; off += (c + 255) >> 8; }
        if (off > SH_TILE0) off = SH_TILE0;
        tab[64] = SEQ; tab[65 + 64] = off; tab[65 + 65] = off + 32; }
    LDS_WAIT(); __syncthreads();
}

__device__ __forceinline__ void p13_final(Frame& F) {
    const int gw = F.vcu * NWAVES + F.wave, NGW = F.G * NWAVES;
    const LAS int* toff = (const LAS int*)(F.lds + TAB_OFF) + 65;
    const int* tokE = (const int*)(F.ws + WS_TOKE); const int* tokS = (const int*)(F.ws + WS_TOKS); const float* tokW = (const float*)(F.ws + WS_TOKW);
    const bf16_t* Y = (const bf16_t*)(F.ws + WS_YROWS); const float* X1 = (const float*)(F.ws + WS_X1);
    f32x4 g5[4][2];
#pragma unroll
    for (int j = 0; j < 4; ++j)
#pragma unroll
        for (int n = 0; n < 2; ++n) g5[j][n] = load_mod4(F, 0, 5, 8 * F.lane + 512 * j + 4 * n);
    for (int t = gw; t < SEQ; t += NGW) {
        f32x4 a[4][2];
        { const bf16_t* yr = Y + ((size_t)SH_TILE0 * 256 + t) * DM + 8 * F.lane;
#pragma unroll
          for (int j = 0; j < 4; ++j) { const u32x4 w = *(const u32x4*)(yr + 512 * j);
              a[j][0] = (f32x4){bflo(w.x), bfhi(w.x), bflo(w.y), bfhi(w.y)}; a[j][1] = (f32x4){bflo(w.z), bfhi(w.z), bflo(w.w), bfhi(w.w)}; } }
#pragma unroll
        for (int k = 0; k < 8; ++k) {
            const int e = __builtin_amdgcn_readfirstlane(tokE[t * 8 + k]), sl = __builtin_amdgcn_readfirstlane(tokS[t * 8 + k]);
            const float wk = __uint_as_float(__builtin_amdgcn_readfirstlane(__float_as_uint(tokW[t * 8 + k])));
            const int ee = (e < 0 || e > 63) ? 0 : e;
            const bf16_t* yr = Y + ((size_t)toff[ee] * 256 + sl) * DM + 8 * F.lane;
#pragma unroll
            for (int j = 0; j < 4; ++j) { const u32x4 w = *(const u32x4*)(yr + 512 * j);
                a[j][0] = a[j][0] + (f32x4){bflo(w.x), bfhi(w.x), bflo(w.y), bfhi(w.y)} * wk; a[j][1] = a[j][1] + (f32x4){bflo(w.z), bfhi(w.z), bflo(w.w), bfhi(w.w)} * wk; }
        }
#pragma unroll
        for (int j = 0; j < 4; ++j)
#pragma unroll
            for (int n = 0; n < 2; ++n) { const size_t o = (size_t)t * DM + 8 * F.lane + 512 * j + 4 * n;
                *(f32x4*)(F.out + o) = *(const f32x4*)(X1 + o) + g5[j][n] * a[j][n]; }
    }
}

constexpr int N_PHASES = 14;
__global__ void __launch_bounds__(NTHREADS, 2) mk_fwd(Args args) {
    extern __shared__ __attribute__((aligned(16))) unsigned char lds[];
    Frame F;
    F.lds = (LAS unsigned char*)lds;
    F.MISC = (volatile LAS unsigned*)(F.lds + MISC_OFF);
    F.tid = threadIdx.x; F.lane = F.tid & 63; F.wave = __builtin_amdgcn_readfirstlane(F.tid >> 6);
    F.G = gridDim.x; { const int bx = blockIdx.x; F.vcu = (F.G % 8 == 0) ? (bx % 8) * (F.G / 8) + bx / 8 : bx; }
    F.ws = args.ws; F.ctl = (unsigned*)(args.ws + WS_CTL); F.out = args.out;
    F.ap = (KArgs)__builtin_amdgcn_kernarg_segment_ptr();
    for (int u = F.tid; u < (LDS_BYTES - LDSCTL_OFF) / 4; u += NTHREADS) ((LAS unsigned*)(F.lds + LDSCTL_OFF))[u] = 0u;
    __syncthreads();
    XcdBarrier bar; bar.bar = F.ctl + CW_BAR; bar.x = 0; bar.st = nullptr;
    if (args.one_launch) bar = xcd_barrier_post(F.ctl + CW_BAR, F.MISC + 8);
    const int lo = args.ph_lo, hi = args.ph_hi;
#ifndef PH_MASK
#define PH_MASK 0x3fff
#endif
#define IN(k) (((PH_MASK >> (k)) & 1) && lo <= (k) && (k) < hi)
#define SEAM(k) do { if (IN(k) && IN((k) + 1)) xcd_barrier(bar); } while (0)

    if (IN(0)) { RELAUNDER(); p0_prologue(F); } SEAM(0);
    if (IN(1)) { RELAUNDER(); norm_mod_rows<false>(F, MT, INP(I_NMIX), 0, (bf16_t*)(F.ws + WS_H), nullptr, true); } SEAM(1);
    if (IN(2)) { RELAUNDER(); pg8::Gemm g{(const bf16_t*)(F.ws + WS_H), (const bf16_t*)(F.ws + WS_WIN), DM, DM, DM}; pg8::StaticOrder S; S.init(MT, INW, F.G, (int)blockIdx.x);
        pg8::EpiBf16 E{(bf16_t*)(F.ws + WS_P), INW};
        pg8::gemm_phase<pg8::EpiBf16, pg8::StaticOrder, true>(F.lds, g, S, E); } SEAM(2);
    if (IN(3)) { RELAUNDER(); p3_headnorm_rope(F); } SEAM(3);
    if (IN(4)) { RELAUNDER();
        const attn::bf16* P = (const attn::bf16*)(F.ws + WS_P);
        for (int i = 0; ; ++i) {
            int he, qb;
            if (F.G == 256) { if (i >= 3) break; he = i * 8 + (F.vcu >> 5); qb = F.vcu & 31; }
            else { const int U = i * F.G + (int)blockIdx.x; if (U >= 768) break; he = U >> 5; qb = U & 31; }
            int qc, kc, vc; float* O;
            if (he < 8) { qc = C_AQ + he * 128; kc = C_AK + (he >> 2) * 128; vc = C_AV + (he >> 2) * 128; O = (float*)(F.ws + WS_OA) + he * 128; }
            else { const int idx = he - 8, h = idx >> 2, m = (idx >> 1) & 1, vh = idx & 1;
                qc = C_BQ + (h * 2 + m) * 128; kc = C_BK + (h * 2 + m) * 128; vc = C_BV + h * 256 + vh * 128; O = (float*)(F.ws + (m ? WS_OB1 : WS_OB0)) + h * 256 + vh * 128; }
            attn::attn_dense_body(P + (size_t)(CTXL + qb * 256) * INW + qc, P + kc, P + vc, O + (size_t)(qb * 256) * 1024, MT, (char*)lds);
        }
    } SEAM(4);
    if (IN(5)) { RELAUNDER(); p5_combine(F); } SEAM(5);
    if (IN(6)) { RELAUNDER(); pg8::Gemm g{(const bf16_t*)(F.ws + WS_A2), (const bf16_t*)(F.ws + WS_WA), DM, 1024, 1024}; pg8::StaticOrder S; S.init(SEQ, DM, F.G, (int)blockIdx.x);
        pg8::EpiGateF32 E{(float*)(F.ws + WS_Y1), DM, (const bf16_t*)(F.ws + WS_P), INW, CTXL, C_GA};
        pg8::gemm_phase<pg8::EpiGateF32, pg8::StaticOrder, false>(F.lds, g, S, E); } SEAM(6);
    if (IN(7)) { RELAUNDER(); pg8::Gemm g{(const bf16_t*)(F.ws + WS_A2) + 1024, (const bf16_t*)(F.ws + WS_WB), DM, 1024, 1024}; pg8::StaticOrder S; S.init(SEQ, DM, F.G, (int)blockIdx.x);
        pg8::EpiGateAddBf16 E{(bf16_t*)(F.ws + WS_Y), DM, (const float*)(F.ws + WS_Y1), (const bf16_t*)(F.ws + WS_P), INW, CTXL, C_GB};
        pg8::gemm_phase<pg8::EpiGateAddBf16, pg8::StaticOrder, false>(F.lds, g, S, E); } SEAM(7);
    if (IN(8)) { RELAUNDER(); pg8::Gemm g{(const bf16_t*)(F.ws + WS_Y), (const bf16_t*)(F.ws + WS_WO), DM, DM, DM}; pg8::StaticOrder S; S.init(SEQ, DM, F.G, (int)blockIdx.x);
        pg8::EpiResidF32 E{(float*)(F.ws + WS_X1), INP(I_X), DM, (const float*)(F.ws + WS_MOD) + 2 * DM};
        pg8::gemm_phase<pg8::EpiResidF32, pg8::StaticOrder, false>(F.lds, g, S, E); } SEAM(8);
    if (IN(9)) { RELAUNDER(); norm_mod_rows<true>(F, SEQ, INP(I_NFFN), 3, (bf16_t*)(F.ws + WS_H2HI), (bf16_t*)(F.ws + WS_H2LO), false); } SEAM(9);
    if (IN(10)) { RELAUNDER(); p10_router(F); } SEAM(10);
    if (IN(11)) { RELAUNDER(); moe_tables(F);
        const LAS int* tab = (const LAS int*)(F.lds + TAB_OFF);
        pg8::Gemm g{(const bf16_t*)(F.ws + WS_H2HI), (const bf16_t*)(F.ws + WS_WGU), DM, DM, DM};
        pg8::MoeOrder S{tab, tab + 65, (const int*)(F.ws + WS_LIST), F.G, F.vcu, 4, __builtin_amdgcn_readfirstlane(tab[65 + 65]) * 4, true};
        pg8::EpiSwiglu E{(bf16_t*)(F.ws + WS_ACT), FE};
        pg8::gemm_phase<pg8::EpiSwiglu, pg8::MoeOrder, true>(F.lds, g, S, E); } SEAM(11);
    if (IN(12)) { RELAUNDER(); moe_tables(F);
        const LAS int* tab = (const LAS int*)(F.lds + TAB_OFF);
        pg8::Gemm g{(const bf16_t*)(F.ws + WS_ACT), (const bf16_t*)(F.ws + WS_WD), FE, FE, FE};
        pg8::MoeOrder S{tab, tab + 65, (const int*)(F.ws + WS_LIST), F.G, F.vcu, 8, __builtin_amdgcn_readfirstlane(tab[65 + 65]) * 8, false};
        pg8::EpiBf16 E{(bf16_t*)(F.ws + WS_YROWS), DM};
        pg8::gemm_phase<pg8::EpiBf16, pg8::MoeOrder, true>(F.lds, g, S, E); } SEAM(12);
    if (IN(13)) { RELAUNDER(); moe_tables(F); p13_final(F); }
#undef IN
#undef SEAM
}

extern "C" void kernel_launch(void* const* d_in, const int* in_sizes, int n_in, void* d_out, int out_size, void* d_ws, size_t ws_size, hipStream_t stream) {
    static int grid = 0;
    if (grid == 0) {
        if (n_in != 29 || in_sizes[0] != SEQ * DM || out_size != SEQ * DM || ws_size < WS_END) {
            fprintf(stderr, "kernel_launch: shape/workspace mismatch: n_in %d in0 %d out %d ws %zu (need %zu)\n", n_in, n_in > 0 ? in_sizes[0] : -1, out_size, ws_size, (size_t)WS_END); grid = -1; return; }
        int dev = 0, cus = 0, per_cu = 0;
        if (hipGetDevice(&dev) != hipSuccess || hipDeviceGetAttribute(&cus, hipDeviceAttributeMultiprocessorCount, dev) != hipSuccess) { grid = -1; return; }
        if (hipFuncSetAttribute((const void*)mk_fwd, hipFuncAttributeMaxDynamicSharedMemorySize, LDS_BYTES) != hipSuccess) { fprintf(stderr, "kernel_launch: hipFuncSetAttribute failed\n"); grid = -1; return; }
        if (hipOccupancyMaxActiveBlocksPerMultiprocessor(&per_cu, (const void*)mk_fwd, NTHREADS, LDS_BYTES) != hipSuccess || per_cu < 1)
            fprintf(stderr, "kernel_launch: occupancy query reports %d\n", per_cu);
        (void)hipGetLastError();
        grid = cus;
    }
    if (grid < 0) return;
    if (hipMemsetAsync((char*)d_ws + WS_CTL, 0, CTL_ZERO_BYTES, stream) != hipSuccess) return;
    Args a{};
    for (int i = 0; i < 29; ++i) a.in[i] = (const float*)d_in[i];
    a.out = (float*)d_out; a.ws = (unsigned char*)d_ws; a.pad = 0;
#if MK_ONE_LAUNCH
    a.ph_lo = 0; a.ph_hi = N_PHASES; a.one_launch = 1;
    hipLaunchKernelGGL(mk_fwd, dim3(grid), dim3(NTHREADS), LDS_BYTES, stream, a);
#else
    for (int p = 0; p < N_PHASES; ++p) { a.ph_lo = p; a.ph_hi = p + 1; a.one_launch = 0;
        hipLaunchKernelGGL(mk_fwd, dim3(grid), dim3(NTHREADS), LDS_BYTES, stream, a); }
#endif
    const hipError_t le = hipPeekAtLastError();
    if (le != hipSuccess) fprintf(stderr, "kernel_launch: launch failed: %s\n", hipGetErrorName(le));
}
```

```cpp
#include <hip/hip_runtime.h>
#include <hip/hip_bf16.h>
#include <cstdio>
#include <cstdint>

#ifndef STAG_TICKS
#define STAG_TICKS 20
#endif
#ifndef RING_COUNTED
#define RING_COUNTED 0
#endif
#ifndef P0_EXPERTS
#define P0_EXPERTS 0
#endif
#ifndef GQA_DMA_BODY
#define GQA_DMA_BODY 1
#endif
#ifndef EPI_TWICE
#define EPI_TWICE 0
#endif
#ifndef HOST_DUP_MASK
#define HOST_DUP_MASK 0
#endif
#ifndef MK_ONE_LAUNCH
#define MK_ONE_LAUNCH 1
#endif

#define GAS __attribute__((address_space(1)))
#define LAS __attribute__((address_space(3)))
typedef unsigned short bf16_t;
typedef short bf16x8 __attribute__((ext_vector_type(8)));
typedef float f32x4 __attribute__((ext_vector_type(4)));
typedef float f32x2 __attribute__((ext_vector_type(2)));
typedef float f32x16 __attribute__((ext_vector_type(16)));
typedef unsigned u32x4 __attribute__((ext_vector_type(4)));
typedef unsigned u32x2 __attribute__((ext_vector_type(2)));
typedef short s16x4 __attribute__((ext_vector_type(4)));

constexpr int DM = 2048, SEQ = 8192, CTXL = 256, MT = SEQ + CTXL;
constexpr int INW = 8704;
constexpr int C_AQ = 0, C_AK = 1024, C_AV = 1280, C_BQ = 1536, C_BK = 2560, C_BV = 3584, C_GA = 4608, C_GB = 6656;
constexpr int NE = 64, TOPK = 8, FE = 512, NMOD = 6;
constexpr int SH_TILE0 = 320;
constexpr int MOE_ROWS = (SH_TILE0 + 32) * 256;
constexpr float EPS = 1e-6f;
__host__ __device__ constexpr int rope_e(int p) { return (((((p >> 3) * 4 + (p & 3)) >> 5) * 64) + ((((p >> 3) * 4 + (p & 3))) & 31) + 32 * ((p >> 2) & 1)); }
__host__ __device__ constexpr bool is_qk_col(int n) { return n < 1280 || (n >= 1536 && n < 3584); }
constexpr int NWAVES = 8, NTHREADS = 512;

constexpr size_t MiB = 1u << 20;
constexpr size_t WS_CTL = 0, CTL_ZERO_BYTES = 1 * MiB;
constexpr size_t WS_MODP = 1 * MiB;
constexpr size_t WS_MOD = WS_MODP + 512 * 1024;
constexpr size_t WS_TOKE = 2 * MiB, WS_TOKS = WS_TOKE + 256 * 1024, WS_TOKW = WS_TOKS + 256 * 1024;
constexpr size_t WS_LIST = 3 * MiB;
constexpr size_t WS_WRHI = 5 * MiB, WS_WRLO = WS_WRHI + 256 * 1024;
constexpr size_t WS_WIN = 8 * MiB;
constexpr size_t WS_WAB = 42 * MiB, WS_WO = 50 * MiB;
constexpr int NP_GU = 1024 + 16, NP_D = 2048 + 16;
constexpr size_t GU_BYTES = (size_t)(DM / 8) * NP_GU * 16, D_BYTES = (size_t)(FE / 8) * NP_D * 16;
constexpr size_t WS_WGU = 58 * MiB;
constexpr size_t WS_WD = 324 * MiB;
constexpr size_t WS_X1 = 456 * MiB;
constexpr size_t WS_CS = WS_X1;
constexpr size_t WS_ACT = 520 * MiB;
constexpr size_t WS_OVER = 608 * MiB;
constexpr size_t WS_YROWS = WS_OVER;
constexpr size_t WS_H = WS_OVER;
constexpr size_t WS_Y = WS_OVER;
constexpr size_t WS_P = WS_OVER + 34 * MiB;
constexpr size_t WS_H2HI = WS_P, WS_H2LO = WS_P + 32 * MiB;
constexpr size_t WS_OA = WS_OVER + 176 * MiB, WS_OB0 = WS_OA + 32 * MiB, WS_OB1 = WS_OB0 + 32 * MiB;
constexpr size_t WS_Y1 = WS_OA;
constexpr size_t WS_A2 = WS_OVER + 272 * MiB;
constexpr size_t WS_END = WS_OVER + 352 * MiB;
static_assert(WS_P + (size_t)MT * INW * 2 <= WS_OA && WS_A2 + 32 * MiB <= WS_END && WS_H + (size_t)MT * DM * 2 <= WS_P, "ws map");
static_assert(WS_WGU + 65 * GU_BYTES <= WS_WD && WS_WD + 65 * D_BYTES <= WS_X1 && WS_X1 + 64 * MiB <= WS_ACT && WS_ACT + (size_t)MOE_ROWS * FE * 2 <= WS_OVER, "ws map 2");
constexpr int CW_TMO = 0;
constexpr int CW_ADA = 2048;
constexpr int CW_CNT = 1024;
constexpr int CW_BAR = 4096;

constexpr int RING_BYTES = 131072;
constexpr int ATT_BYTES = 3 * 16384 + 3 * 32768 + 2048;
constexpr int LDSCTL_OFF = 150528, MISC_OFF = LDSCTL_OFF + 320, TAB_OFF = LDSCTL_OFF + 1024;
constexpr int LDS_BYTES = 163840;
static_assert(ATT_BYTES <= LDSCTL_OFF && RING_BYTES <= LDSCTL_OFF && TAB_OFF + 1024 <= LDS_BYTES, "LDS map");

#define RLX_AGENT __ATOMIC_RELAXED, __HIP_MEMORY_SCOPE_AGENT
#define LDS_WAIT() asm volatile("s_waitcnt lgkmcnt(0)" ::: "memory")
#define VM_WAIT() asm volatile("s_waitcnt vmcnt(0)" ::: "memory")
__device__ __forceinline__ int lane_id_v() { int l; asm volatile("v_mbcnt_lo_u32_b32 %0, -1, 0\n\tv_mbcnt_hi_u32_b32 %0, -1, %0" : "=v"(l)); return l; }
__device__ __forceinline__ unsigned f2bf(float f) { unsigned u = __builtin_bit_cast(unsigned, f); return (u + 0x7fffu + ((u >> 16) & 1u)) >> 16; }
__device__ __forceinline__ unsigned pk2(float lo, float hi) { return f2bf(lo) | (f2bf(hi) << 16); }
__device__ __forceinline__ float bf2f(unsigned short b) { return __uint_as_float((unsigned)b << 16); }
__device__ __forceinline__ float bflo(unsigned w) { return __uint_as_float(w << 16); }
__device__ __forceinline__ float bfhi(unsigned w) { return __uint_as_float(w & 0xffff0000u); }
__device__ __forceinline__ unsigned cvt_pk_bf16(float lo, float hi) { unsigned r; asm volatile("v_cvt_pk_bf16_f32 %0, %1, %2" : "=v"(r) : "v"(lo), "v"(hi)); return r; }
__device__ __forceinline__ float sigmoidf_(float x) { return __builtin_amdgcn_rcpf(1.0f + __expf(-x)); }
__device__ __forceinline__ float wave_sum(float v) {
#pragma unroll
    for (int o = 1; o < 64; o <<= 1) v += __shfl_xor(v, o);
    return v;
}

#define XB_TMO      128
#define XB_XCNT(j)  (256  + 64 * (j))
#define XB_XSUB(j)  (1280 + 64 * (j))
#define XB_XGEN(j)  (2304 + 64 * (j))
#define XB_TOP      3328
#define XB_TOPGEN   3392
#define XCD_BAR_WORDS 3456
#define XB_SPIN_CAP (1u << 18)
__device__ __forceinline__ unsigned xb_ld(unsigned* p)              { return __hip_atomic_load(p, __ATOMIC_RELAXED, __HIP_MEMORY_SCOPE_AGENT); }
__device__ __forceinline__ unsigned xb_add(unsigned* p, unsigned v) { return __hip_atomic_fetch_add(p, v, __ATOMIC_RELAXED, __HIP_MEMORY_SCOPE_AGENT); }
__device__ __forceinline__ unsigned xb_xcc_id() { return (unsigned)__builtin_amdgcn_s_getreg((3 << 11) | 20) & 0xFu; }
#define XB_SPIN(cond, bar) do { unsigned _sp = 0; while (cond) { __builtin_amdgcn_s_sleep(1); \
    if ((++_sp & 255u) == 0u) { if (xb_ld(&(bar)[XB_TMO])) break; if (_sp > XB_SPIN_CAP) { atomicAdd(&(bar)[XB_TMO], 1u); break; } } } } while (0)
struct XcdBarrier { unsigned* bar; unsigned x; volatile LAS unsigned* st; };
__device__ __forceinline__ XcdBarrier xcd_barrier_post(unsigned* bar, volatile LAS unsigned* st, bool leader) {
    XcdBarrier b; b.bar = bar; b.x = xb_xcc_id(); b.st = st;
    if (leader) (void)xb_add(&bar[XB_XCNT(b.x)], 1u);
    return b;
}
__device__ __forceinline__ void xcd_barrier_complete(unsigned* bar, unsigned x, unsigned& nloc, unsigned& nx) {
    const unsigned G = gridDim.x * gridDim.y * gridDim.z;
    unsigned sum, cnt, mine, sp = 0u;
    for (;;) {
        sum = 0u; cnt = 0u; mine = 0u;
#pragma unroll
        for (unsigned j = 0; j < 16; ++j) { const unsigned c = xb_ld(&bar[XB_XCNT(j)]); sum += c; cnt += (c > 0u) ? 1u : 0u; mine = (j == x) ? c : mine; }
        if (sum == G) break;
        __builtin_amdgcn_s_sleep(1);
        if ((++sp & 255u) == 0u) { if (xb_ld(&bar[XB_TMO])) break; if (sp > XB_SPIN_CAP) { atomicAdd(&bar[XB_TMO], 1u); break; } }
    }
    nloc = mine > 0u ? mine : 1u; nx = cnt > 0u ? cnt : 1u;
}
__device__ __forceinline__ void xcd_barrier(const XcdBarrier& b, int wave) {
    asm volatile("s_waitcnt vmcnt(0)" ::: "memory");
    __syncthreads();
    if (wave == 0 && lane_id_v() == 0) {
        unsigned* bar = b.bar;
        __builtin_amdgcn_s_waitcnt(0);
        unsigned nloc = b.st[0], nx = b.st[1];
        if (nloc == 0u) { xcd_barrier_complete(bar, b.x, nloc, nx); b.st[0] = nloc; b.st[1] = nx; }
        const unsigned old = xb_add(&bar[XB_XSUB(b.x)], 1u);
        const unsigned gen = old / nloc;
        if (old + 1u == (gen + 1u) * nloc) {
            __builtin_amdgcn_fence(__ATOMIC_RELEASE, "agent");
            asm volatile("s_waitcnt vmcnt(0)" ::: "memory");
            const unsigned og = xb_add(&bar[XB_TOP], 1u);
            const unsigned tg = og / nx;
            if (og + 1u == (tg + 1u) * nx) xb_add(&bar[XB_TOPGEN], 1u);
            else XB_SPIN(xb_ld(&bar[XB_TOPGEN]) == tg, bar);
            __builtin_amdgcn_fence(__ATOMIC_ACQUIRE, "agent");
            xb_add(&bar[XB_XGEN(b.x)], 1u);
            asm volatile("s_waitcnt vmcnt(0)" ::: "memory");
        } else {
            XB_SPIN(xb_ld(&bar[XB_XGEN(b.x)]) == gen, bar);
            __builtin_amdgcn_fence(__ATOMIC_ACQUIRE, "agent");
            asm volatile("s_waitcnt vmcnt(0)" ::: "memory");
        }
    }
    __syncthreads();
}

namespace pg8 {
constexpr int BM = 256, BK = 64, HALF = 128, HTB = HALF * BK * 2, STAGE_BYTES = 8 * HTB;
__host__ __device__ __forceinline__ int lds_byte(int r, int c) { const int st = (r >> 4) * 2 + (c >> 5), rr = r & 15, cc = c & 31, ob = rr * 64 + cc * 2; return st * 1024 + (ob ^ (((ob >> 9) & 1) << 5)); }
__host__ __device__ __forceinline__ void stage_rc(int b, int& R, int& C) { const int st = b / 1024, sb = b % 1024, swz = sb ^ (((sb >> 9) & 1) << 5); R = (st >> 1) * 16 + swz / 64; C = (st & 1) * 32 + (swz % 64) / 2; }
__host__ __device__ __forceinline__ int perm32(int rho) { const int n = rho >> 4, i = rho & 15; return 8 * (i >> 2) + 4 * n + (i & 3); }

struct Unit { int pm, pn, pb, e, mt, cnt; };
struct Gemm { const bf16_t* A; const bf16_t* Bt; int lda, ldb, K; int nNb; size_t matBytes; };

struct StaticOrder {
    int nM, nN, nwg, G, c;
    __device__ void init(int M, int N, int G_, int c_) { nM = M / BM; nN = N / BM; nwg = nM * nN; G = G_; c = c_; }
    __device__ __forceinline__ bool next(int i, Unit& u) const {
        const long L = (long)i * G + c; if (L >= nwg) return false;
        int wgid = (int)L; { const int q = nwg / 8, r = nwg % 8, xcd = wgid % 8, off = wgid / 8; wgid = (xcd < r ? xcd * (q + 1) : r * (q + 1) + (xcd - r) * q) + off; }
        const int nig = 8 * nN, gid = wgid / nig, fm = gid * 8, gsz = (nM - fm) < 8 ? (nM - fm) : 8;
        u.pm = fm + ((wgid % nig) % gsz); u.pn = (wgid % nig) / gsz; u.pb = u.pn; u.e = 0; u.mt = 0; u.cnt = 0; return true;
    }
    __device__ __forceinline__ int arow(const Unit& u, int r) const { return u.pm * BM + r; }
};
struct MoeOrder {
    const LAS int* cnt; const LAS int* toff; const int* list; int G, c, nN, total; bool gather;
    __device__ __forceinline__ bool next(int i, Unit& u) const {
        const int L = i * G + c; if (L >= total) return false;
        const int rt = L / nN, nt = L % nN;
        int e = 0;
#pragma unroll
        for (int j = 64; j >= 1; j >>= 1) { const int t = e + j; if (t <= 64 && toff[t] <= rt) e = t; }
        e = __builtin_amdgcn_readfirstlane(e);
        const int mt = rt - __builtin_amdgcn_readfirstlane(toff[e]);
        u.e = e; u.mt = mt; u.cnt = __builtin_amdgcn_readfirstlane(cnt[e]);
        u.pm = (e < 64) ? rt : SH_TILE0 + mt; u.pn = nt; u.pb = e * nN + nt; return true;
    }
    __device__ __forceinline__ int arow(const Unit& u, int r) const {
        if (!gather) return u.pm * BM + r;
        const int s = u.mt * BM + r;
        if (u.e == 64) return s;
        return s < u.cnt ? list[u.e * SEQ + s] : 0;
    }
};

#define EPI_LOOP_BEGIN int row0_ = u.pm * BM + wr * 64 + fr; int colL_ = wc * 32 + 8 * fq; asm volatile("" : "+v"(row0_), "+v"(colL_));     \
    _Pragma("unroll") for (int ai = 0; ai < 2; ++ai) _Pragma("unroll") for (int m = 0; m < 4; ++m) { const int row = row0_ + ai * HALF + m * 16;
#define EPI_LOOP_END }

struct EpiBf16 {
    static constexpr bool MIDHOOK = false;
    bf16_t* O; int ldc;
    __device__ __forceinline__ void operator()(const f32x4 (&acc)[2][2][4][2], const Unit& u, int wr, int wc, int fr, int fq) const {
        EPI_LOOP_BEGIN
            bf16_t* rowp = O + (size_t)row * ldc + u.pn * BM + colL_;
#pragma unroll
            for (int bj = 0; bj < 2; ++bj) { const f32x4 v0 = acc[ai][bj][m][0], v1 = acc[ai][bj][m][1];
                u32x4 w; w.x = cvt_pk_bf16(v0[0], v0[1]); w.y = cvt_pk_bf16(v0[2], v0[3]); w.z = cvt_pk_bf16(v1[0], v1[1]); w.w = cvt_pk_bf16(v1[2], v1[3]);
                *(u32x4*)(rowp + bj * HALF) = w; }
        EPI_LOOP_END
    }
};
struct EpiFp8 {
    static constexpr bool MIDHOOK = false;
    unsigned char* O; int ldc;
    __device__ __forceinline__ void operator()(const f32x4 (&acc)[2][2][4][2], const Unit& u, int wr, int wc, int fr, int fq) const {
        EPI_LOOP_BEGIN
            unsigned char* rowp = O + (size_t)row * ldc + u.pn * BM + colL_;
#pragma unroll
            for (int bj = 0; bj < 2; ++bj) { f32x4 v0 = acc[ai][bj][m][0] * 32.0f, v1 = acc[ai][bj][m][1] * 32.0f;
#pragma unroll
                for (int q = 0; q < 4; ++q) { v0[q] = __builtin_amdgcn_fmed3f(v0[q], -440.0f, 440.0f); v1[q] = __builtin_amdgcn_fmed3f(v1[q], -440.0f, 440.0f); }
                int w0 = __builtin_amdgcn_cvt_pk_fp8_f32(v0[0], v0[1], 0, false); w0 = __builtin_amdgcn_cvt_pk_fp8_f32(v0[2], v0[3], w0, true);
                int w1 = __builtin_amdgcn_cvt_pk_fp8_f32(v1[0], v1[1], 0, false); w1 = __builtin_amdgcn_cvt_pk_fp8_f32(v1[2], v1[3], w1, true);
                u32x2 w; w.x = (unsigned)w0; w.y = (unsigned)w1; *(u32x2*)(rowp + bj * HALF) = w; }
        EPI_LOOP_END
    }
};
struct EpiProj {
    static constexpr bool MIDHOOK = false;
    bf16_t* O; int ldc; const float* gqa; const float* gka; const float* gqb; const float* gkb; const f32x4* cs; LAS float* ps;
    __device__ __forceinline__ void operator()(f32x4 (&acc)[2][2][4][2], const Unit& u, int wr, int wc, int fr, int fq) const {
        const int pn = u.pn;
        const bool isq = pn < 4 || (pn >= 6 && pn < 10), isk = pn == 4 || (pn >= 10 && pn < 14);
        if (isq || isk) {
            const bool lat = u.pm > 0;
#pragma unroll
            for (int ai = 0; ai < 2; ++ai)
#pragma unroll
                for (int m = 0; m < 4; ++m)
#pragma unroll
                    for (int bj = 0; bj < 2; ++bj) { const f32x4 a = acc[ai][bj][m][0], b = acc[ai][bj][m][1];
                        float ss = (a[0] * a[0] + a[1] * a[1]) + (a[2] * a[2] + a[3] * a[3]) + (b[0] * b[0] + b[1] * b[1]) + (b[2] * b[2] + b[3] * b[3]);
                        ss += __shfl_xor(ss, 16); ss += __shfl_xor(ss, 32);
                        if (fq == 0) ps[((ai * HALF + wr * 64 + m * 16 + fr) * 2 + bj) * 4 + wc] = ss; }
            asm volatile("s_waitcnt lgkmcnt(0)" ::: "memory"); __builtin_amdgcn_s_barrier(); asm volatile("" ::: "memory");
            const int pi0 = (4 * wc + fq) * 4, e0 = ((pi0 >> 5) * 64) + (pi0 & 31);
            f32x4 g1, g2;
            { const f32x4 a1 = *(const f32x4*)(gqa + e0), a2 = *(const f32x4*)(gqa + e0 + 32), b1 = *(const f32x4*)(gka + e0), b2 = *(const f32x4*)(gka + e0 + 32);
              const f32x4 c1 = *(const f32x4*)(gqb + e0), c2 = *(const f32x4*)(gqb + e0 + 32), d1 = *(const f32x4*)(gkb + e0), d2 = *(const f32x4*)(gkb + e0 + 32);
              const float wa = pn < 4 ? 1.f : 0.f, wb = pn == 4 ? 1.f : 0.f, wc_ = (pn >= 6 && pn < 10) ? 1.f : 0.f, wd = pn >= 10 ? 1.f : 0.f;
              g1 = a1 * wa + b1 * wb + c1 * wc_ + d1 * wd; g2 = a2 * wa + b2 * wb + c2 * wc_ + d2 * wd; }
            int row0_ = u.pm * BM + wr * 64 + fr; asm volatile("" : "+v"(row0_));
#pragma unroll
            for (int ai = 0; ai < 2; ++ai)
#pragma unroll
                for (int m = 0; m < 4; ++m) { const int rl = ai * HALF + wr * 64 + m * 16 + fr, row = row0_ + ai * HALF + m * 16;
                    f32x4 c4 = {1.f, 1.f, 1.f, 1.f}, s4 = {0.f, 0.f, 0.f, 0.f};
                    if (lat) { const f32x4* cp = cs + ((size_t)(row - CTXL) * 64 + pi0) / 2; const f32x4 x0 = cp[0], x1 = cp[1];
                        c4 = (f32x4){x0[0], x0[2], x1[0], x1[2]}; s4 = (f32x4){x0[1], x0[3], x1[1], x1[3]}; }
#pragma unroll
                    for (int bj = 0; bj < 2; ++bj) { const f32x4 p4 = *(const LAS f32x4*)(ps + (rl * 2 + bj) * 4);
                        const float rstd = 1.0f / sqrtf(((p4[0] + p4[1]) + (p4[2] + p4[3])) * (1.0f / 128.0f) + EPS);
                        const f32x4 u1 = acc[ai][bj][m][0] * rstd * g1, u2 = acc[ai][bj][m][1] * rstd * g2;
                        acc[ai][bj][m][0] = u1 * c4 - u2 * s4; acc[ai][bj][m][1] = u1 * s4 + u2 * c4; }
                    asm volatile("" : "+v"(acc[ai][0][m][0]), "+v"(acc[ai][0][m][1]), "+v"(acc[ai][1][m][0]), "+v"(acc[ai][1][m][1]) :: "memory"); }
        }
        EPI_LOOP_BEGIN
            bf16_t* rowp = O + (size_t)row * ldc + u.pn * BM + colL_;
#pragma unroll
            for (int bj = 0; bj < 2; ++bj) { const f32x4 v0 = acc[ai][bj][m][0], v1 = acc[ai][bj][m][1];
                u32x4 w; w.x = cvt_pk_bf16(v0[0], v0[1]); w.y = cvt_pk_bf16(v0[2], v0[3]); w.z = cvt_pk_bf16(v1[0], v1[1]); w.w = cvt_pk_bf16(v1[2], v1[3]);
                *(u32x4*)(rowp + bj * HALF) = w; }
        EPI_LOOP_END
    }
};
struct EpiGate2Bf16 {
    static constexpr bool MIDHOOK = true;
    bf16_t* O; int ldc; const bf16_t* Gt; int ldg; int grow0, gcolA, gcolB;
    __device__ __forceinline__ void mid(f32x4 (&acc)[2][2][4][2], const Unit& u, int wr, int wc, int fr, int fq) const {
        EPI_LOOP_BEGIN
            const bf16_t* gp = Gt + (size_t)(row + grow0) * ldg + u.pn * BM + colL_;
#pragma unroll
            for (int bj = 0; bj < 2; ++bj) { const u32x4 ga = *(const u32x4*)(gp + gcolA + bj * HALF), gb = *(const u32x4*)(gp + gcolB + bj * HALF);
#define RAT(wa_, wb_, f_) ((1.0f + __expf(-f_(wb_))) * __builtin_amdgcn_rcpf(1.0f + __expf(-f_(wa_))))
                f32x4 r0, r1;
                r0[0] = RAT(ga.x, gb.x, bflo); r0[1] = RAT(ga.x, gb.x, bfhi); r0[2] = RAT(ga.y, gb.y, bflo); r0[3] = RAT(ga.y, gb.y, bfhi);
                r1[0] = RAT(ga.z, gb.z, bflo); r1[1] = RAT(ga.z, gb.z, bfhi); r1[2] = RAT(ga.w, gb.w, bflo); r1[3] = RAT(ga.w, gb.w, bfhi);
#undef RAT
                acc[ai][bj][m][0] = acc[ai][bj][m][0] * r0; acc[ai][bj][m][1] = acc[ai][bj][m][1] * r1; }
            asm volatile("" : "+v"(acc[ai][0][m][0]), "+v"(acc[ai][0][m][1]), "+v"(acc[ai][1][m][0]), "+v"(acc[ai][1][m][1]) :: "memory");
        EPI_LOOP_END
    }
    __device__ __forceinline__ void operator()(const f32x4 (&acc)[2][2][4][2], const Unit& u, int wr, int wc, int fr, int fq) const {
        EPI_LOOP_BEGIN
            const size_t co = (size_t)row * ldc + u.pn * BM + colL_;
            const bf16_t* gp = Gt + (size_t)(row + grow0) * ldg + gcolB + u.pn * BM + colL_;
#pragma unroll
            for (int bj = 0; bj < 2; ++bj) { const u32x4 g = *(const u32x4*)(gp + bj * HALF); const f32x4 v0 = acc[ai][bj][m][0], v1 = acc[ai][bj][m][1];
                f32x4 o0, o1;
                o0[0] = v0[0] * sigmoidf_(bflo(g.x)); o0[1] = v0[1] * sigmoidf_(bfhi(g.x)); o0[2] = v0[2] * sigmoidf_(bflo(g.y)); o0[3] = v0[3] * sigmoidf_(bfhi(g.y));
                o1[0] = v1[0] * sigmoidf_(bflo(g.z)); o1[1] = v1[1] * sigmoidf_(bfhi(g.z)); o1[2] = v1[2] * sigmoidf_(bflo(g.w)); o1[3] = v1[3] * sigmoidf_(bfhi(g.w));
                u32x4 w; w.x = cvt_pk_bf16(o0[0], o0[1]); w.y = cvt_pk_bf16(o0[2], o0[3]); w.z = cvt_pk_bf16(o1[0], o1[1]); w.w = cvt_pk_bf16(o1[2], o1[3]);
                *(u32x4*)(O + co + bj * HALF) = w; }
        EPI_LOOP_END
    }
};
struct EpiResidF32 {
    static constexpr bool MIDHOOK = false;
    float* O; const float* X; int ldc; const float* gate;
    __device__ __forceinline__ void operator()(const f32x4 (&acc)[2][2][4][2], const Unit& u, int wr, int wc, int fr, int fq) const {
        const int colL0 = u.pn * BM + wc * 32 + 8 * fq;
        f32x4 gv[2][2];
#pragma unroll
        for (int bj = 0; bj < 2; ++bj)
#pragma unroll
            for (int n = 0; n < 2; ++n) gv[bj][n] = *(const f32x4*)(gate + colL0 + bj * HALF + 4 * n);
        EPI_LOOP_BEGIN
            const size_t co = (size_t)row * ldc + u.pn * BM + colL_;
#pragma unroll
            for (int bj = 0; bj < 2; ++bj)
#pragma unroll
                for (int n = 0; n < 2; ++n) { const f32x4 x = *(const f32x4*)(X + co + bj * HALF + 4 * n);
                    *(f32x4*)(O + co + bj * HALF + 4 * n) = x + gv[bj][n] * acc[ai][bj][m][n]; }
        EPI_LOOP_END
    }
};
struct EpiSwiglu {
    static constexpr bool MIDHOOK = false;
    bf16_t* O; int ldc;
    __device__ __forceinline__ void operator()(const f32x4 (&acc)[2][2][4][2], const Unit& u, int wr, int wc, int fr, int fq) const {
        EPI_LOOP_BEGIN
            bf16_t* rowp = O + (size_t)row * ldc + u.pn * HALF + colL_;
            f32x4 o[2];
#pragma unroll
            for (int n = 0; n < 2; ++n) { const f32x4 g = acc[ai][0][m][n], up = acc[ai][1][m][n];
#pragma unroll
                for (int j = 0; j < 4; ++j) o[n][j] = g[j] * sigmoidf_(g[j]) * up[j]; }
            u32x4 w; w.x = cvt_pk_bf16(o[0][0], o[0][1]); w.y = cvt_pk_bf16(o[0][2], o[0][3]); w.z = cvt_pk_bf16(o[1][0], o[1][1]); w.w = cvt_pk_bf16(o[1][2], o[1][3]);
            *(u32x4*)rowp = w;
        EPI_LOOP_END
    }
};

template <class Epi, class Sched, bool ALIGN_EPI>
__device__ __forceinline__ void gemm_phase(LAS unsigned char* lds, const Gemm g, const Sched& S, const Epi& E, int tid) {
    asm volatile("" : "+v"(tid));
    const int wid = __builtin_amdgcn_readfirstlane(tid >> 6), lane = tid & 63, wr = wid >> 2, wc = wid & 3, fr = lane & 15, fq = lane >> 4;
    const int K = g.K, nt = K / BK, lda = g.lda, ldb = g.ldb;
    int Rr[2], Cc[2]; unsigned voffB[2];
#pragma unroll
    for (int i = 0; i < 2; ++i) { int R, C; stage_rc(tid * 16 + i * 8192, R, C); Rr[i] = R; Cc[i] = C; const int Rb = (R & ~31) + perm32(R & 31);
        voffB[i] = (unsigned)((C >> 3) * ldb + Rb) * 16u; }
    const size_t kstep = (size_t)(BK * 2);
    const size_t kstepB = (size_t)8 * ldb * 16;
    const size_t hstepB = (size_t)HALF * 16;
#define PG8_BBASE(pb_) ((const char*)g.Bt + (size_t)((pb_) / g.nNb) * g.matBytes + (size_t)((pb_) % g.nNb) * (BM * 16))
    const unsigned ldsw = (unsigned)wid * 1024u;
    const int aoff = lds_byte(wr * 64 + fr, fq * 8), boff = lds_byte(wc * 32 + fr, fq * 8);
#define PG8_SA(b, h) (((b) * 2 + (h)) * HTB)
#define PG8_SB(b, h) ((4 + (b) * 2 + (h)) * HTB)
#define PG8_STAGE2(bufoff, gbase, v0, v1) do { \
        __builtin_amdgcn_global_load_lds((const unsigned*)((const char*)(gbase) + (v0)), (LAS unsigned*)(lds + (bufoff) + ldsw), 16, 0, 0); \
        __builtin_amdgcn_global_load_lds((const unsigned*)((const char*)(gbase) + (v1)), (LAS unsigned*)(lds + (bufoff) + ldsw + 8192), 16, 0, 0); } while (0)
#define PG8_STAGEB(bufoff, gbase) PG8_STAGE2(bufoff, gbase, voffB[0], voffB[1])
#define PG8_LDA(dst, b, h) do { _Pragma("unroll") for (int m = 0; m < 4; ++m) _Pragma("unroll") for (int k = 0; k < 2; ++k) dst[m][k] = *(const LAS bf16x8*)(lds + PG8_SA(b, h) + aoff + m * 2048 + k * 1024); } while (0)
#define PG8_LDB(dst, b, h) do { _Pragma("unroll") for (int n = 0; n < 2; ++n) _Pragma("unroll") for (int k = 0; k < 2; ++k) dst[n][k] = *(const LAS bf16x8*)(lds + PG8_SB(b, h) + boff + n * 2048 + k * 1024); } while (0)
#define PG8_MMA(ai, bj, At, Bt) do { __builtin_amdgcn_s_setprio(1); _Pragma("unroll") for (int m = 0; m < 4; ++m) _Pragma("unroll") for (int n = 0; n < 2; ++n) _Pragma("unroll") for (int k = 0; k < 2; ++k) \
        acc[ai][bj][m][n] = __builtin_amdgcn_mfma_f32_16x16x32_bf16(Bt[n][k], At[m][k], acc[ai][bj][m][n], 0, 0, 0); __builtin_amdgcn_s_setprio(0); } while (0)
#define PG8_WAIT_V(n) asm volatile("s_waitcnt vmcnt(" #n ")" ::: "memory")
#define PG8_WAIT_L(n) asm volatile("s_waitcnt lgkmcnt(" #n ")" ::: "memory")
#define PG8_BAR __builtin_amdgcn_s_barrier()
#define PG8_SCHED __builtin_amdgcn_sched_barrier(0)
#define PG8_SETAO(dst, uu) do { _Pragma("unroll") for (int h_ = 0; h_ < 2; ++h_) _Pragma("unroll") for (int i_ = 0; i_ < 2; ++i_) \
        dst[h_][i_] = (unsigned)(S.arow(uu, h_ * HALF + Rr[i_]) * lda + Cc[i_]) * 2u; } while (0)
    Unit cur, nxt; int ui = 0;
    if (!S.next(0, cur)) return;
    f32x4 acc[2][2][4][2];
#pragma unroll
    for (int a = 0; a < 2; ++a)
#pragma unroll
        for (int b = 0; b < 2; ++b)
#pragma unroll
            for (int m = 0; m < 4; ++m)
#pragma unroll
                for (int n = 0; n < 2; ++n) acc[a][b][m][n] = (f32x4){0.f, 0.f, 0.f, 0.f};
    bf16x8 At[4][2], B0[2][2], B1[2][2];
    unsigned aoC[2][2], aoN[2][2];
    PG8_SETAO(aoC, cur);
    const char* gA = (const char*)g.A;
    const char* cB = PG8_BBASE(cur.pb);
    PG8_STAGEB(PG8_SB(0, 0), cB); PG8_STAGEB(PG8_SB(0, 1), cB + hstepB); PG8_STAGE2(PG8_SA(0, 0), gA, aoC[0][0], aoC[0][1]); PG8_STAGE2(PG8_SA(0, 1), gA, aoC[1][0], aoC[1][1]);
    if (wr == 1) PG8_BAR;
    PG8_WAIT_V(2); PG8_BAR;
    PG8_STAGEB(PG8_SB(1, 0), cB + kstepB); PG8_STAGE2(PG8_SA(1, 0), gA + kstep, aoC[0][0], aoC[0][1]); PG8_STAGEB(PG8_SB(1, 1), cB + hstepB + kstepB);
    PG8_WAIT_V(6); PG8_BAR;
    for (;;) {
        const bool has_next = S.next(ui + 1, nxt);
        if (has_next) { PG8_SETAO(aoN, nxt); }
        else {
#pragma unroll
            for (int h_ = 0; h_ < 2; ++h_)
#pragma unroll
                for (int i_ = 0; i_ < 2; ++i_) aoN[h_][i_] = aoC[h_][i_];
        }
        const char* nB = has_next ? PG8_BBASE(nxt.pb) : cB;
        for (int t = 0; t < nt; t += 2) {
            const bool last = (t == nt - 2);
            if constexpr (Epi::MIDHOOK) { if (t == (nt >> 1)) E.mid(acc, cur, wr, wc, fr, fq); }
            const char* a1 = gA + (size_t)(t + 1) * kstep;
            const char* a2 = last ? gA : gA + (size_t)(t + 2) * kstep; const char* b2 = last ? nB : cB + (size_t)(t + 2) * kstepB;
            const char* a3 = a2 + kstep; const char* b3 = b2 + kstepB;
            const unsigned x00 = last ? aoN[0][0] : aoC[0][0], x01 = last ? aoN[0][1] : aoC[0][1], x10 = last ? aoN[1][0] : aoC[1][0], x11 = last ? aoN[1][1] : aoC[1][1];
            PG8_LDB(B0, 0, 0); PG8_LDB(B1, 0, 1); PG8_SCHED; PG8_LDA(At, 0, 0); PG8_STAGE2(PG8_SA(1, 1), a1, aoC[1][0], aoC[1][1]);
            PG8_WAIT_V(8); PG8_WAIT_L(0); PG8_BAR; PG8_MMA(0, 0, At, B0); PG8_MMA(0, 1, At, B1); PG8_BAR; PG8_SCHED;
            PG8_LDA(At, 0, 1); PG8_STAGEB(PG8_SB(0, 0), b2); PG8_STAGEB(PG8_SB(0, 1), b2 + hstepB); PG8_STAGE2(PG8_SA(0, 0), a2, x00, x01);
            PG8_WAIT_V(8); PG8_WAIT_L(0); PG8_BAR; PG8_MMA(1, 0, At, B0); PG8_MMA(1, 1, At, B1); PG8_BAR; PG8_SCHED;
            PG8_LDB(B0, 1, 0); PG8_LDB(B1, 1, 1); PG8_SCHED; PG8_LDA(At, 1, 0); PG8_STAGE2(PG8_SA(0, 1), a2, x10, x11);
            PG8_WAIT_V(8); PG8_WAIT_L(0); PG8_BAR; PG8_MMA(0, 0, At, B0); PG8_MMA(0, 1, At, B1); PG8_BAR; PG8_SCHED;
            PG8_LDA(At, 1, 1); PG8_STAGEB(PG8_SB(1, 0), b3); PG8_STAGEB(PG8_SB(1, 1), b3 + hstepB); PG8_STAGE2(PG8_SA(1, 0), a3, x00, x01);
            PG8_WAIT_V(8); PG8_WAIT_L(0); PG8_BAR; PG8_MMA(1, 0, At, B0); PG8_MMA(1, 1, At, B1); PG8_BAR; PG8_SCHED;
        }
        if constexpr (ALIGN_EPI) { if (wr == 0) PG8_BAR; }
        E(acc, cur, wr, wc, fr, fq);
#if EPI_TWICE
        asm volatile("" ::: "memory"); E(acc, cur, wr, wc, fr, fq);
#endif
        if (!has_next) break;
#pragma unroll
        for (int a = 0; a < 2; ++a)
#pragma unroll
            for (int b = 0; b < 2; ++b)
#pragma unroll
                for (int m = 0; m < 4; ++m)
#pragma unroll
                    for (int n = 0; n < 2; ++n) acc[a][b][m][n] = (f32x4){0.f, 0.f, 0.f, 0.f};
        cur = nxt; cB = nB; ++ui;
#pragma unroll
        for (int h_ = 0; h_ < 2; ++h_)
#pragma unroll
            for (int i_ = 0; i_ < 2; ++i_) aoC[h_][i_] = aoN[h_][i_];
        if constexpr (ALIGN_EPI) { if (wr == 1) PG8_BAR; }
    }
    PG8_WAIT_V(0);
    if constexpr (!ALIGN_EPI) { if (wr == 0) PG8_BAR; }
    PG8_BAR;
#undef PG8_SA
#undef PG8_SB
#undef PG8_STAGE2
#undef PG8_STAGEB
#undef PG8_LDA
#undef PG8_LDB
#undef PG8_MMA
#undef PG8_WAIT_V
#undef PG8_WAIT_L
#undef PG8_BAR
#undef PG8_SCHED
#undef PG8_SETAO
#undef PG8_BBASE
}
}

__device__ __forceinline__ void cvt_load8(float (&v)[8], const float* src, int ld);
namespace attn {
using bf16 = __hip_bfloat16;
constexpr int D = 128, NW = 8, QBLK = 32, KVBLK = 64;
constexpr float SCALE = 0.088388347648318440f;
constexpr float THR = 8.f;
constexpr int LDQ = INW, LDK = INW, LDO = 1024;
constexpr size_t SHM_V = KVBLK * D * 2, SHM_K = KVBLK * D * 2, SHM_ATTN = 2 * SHM_V + 2 * SHM_K + NW * 64 * 4;
#define KSWZ(row, colB) ((row) * 256 + ((colB) ^ (((row) & 7) << 4)))
#define SBAR() __builtin_amdgcn_sched_barrier(0)
__device__ __forceinline__ int crow(int r, int hi) { return (r & 3) + 8 * (r >> 2) + 4 * hi; }
__device__ __forceinline__ unsigned cvtpk(float lo, float hi) { unsigned r; asm volatile("v_cvt_pk_bf16_f32 %0, %1, %2" : "=v"(r) : "v"(lo), "v"(hi)); return r; }
__device__ __forceinline__ bf16x8 ld8(const bf16* p) { return *reinterpret_cast<const bf16x8*>(p); }

__device__ __forceinline__ void partialSM(f32x16& p0, f32x16& p1, float& m_reg, float& mn, float& alpha) {
  constexpr float C = SCALE * 1.4426950408889634f;
  float pmax = p0[0];
#pragma unroll
  for (int r = 1; r < 16; ++r) pmax = fmaxf(pmax, p0[r]);
#pragma unroll
  for (int r = 0; r < 16; ++r) pmax = fmaxf(pmax, p1[r]);
  { auto rr = __builtin_amdgcn_permlane32_swap(__float_as_uint(pmax), __float_as_uint(pmax), false, false);
    pmax = fmaxf(__uint_as_float(rr[0]), __uint_as_float(rr[1])); }
  if (__builtin_expect(__all(pmax - m_reg <= THR / SCALE), 1)) { mn = m_reg; alpha = 1.f; }
  else { mn = fmaxf(m_reg, pmax); alpha = __builtin_amdgcn_exp2f((m_reg - mn) * C); m_reg = mn; }
  float mnC = -mn * C;
#pragma unroll
  for (int r = 0; r < 16; ++r) p0[r] = fmaf(p0[r], C, mnC);
#pragma unroll
  for (int r = 0; r < 16; ++r) p1[r] = fmaf(p1[r], C, mnC);
#pragma unroll
  for (int r = 0; r < 16; ++r) p0[r] = __builtin_amdgcn_exp2f(p0[r]);
}
__device__ __forceinline__ void finishSM(f32x16& p0, f32x16& p1, float alpha, float& l_reg, bf16x8& pa0, bf16x8& pa1, bf16x8& pa2, bf16x8& pa3) {
#pragma unroll
  for (int r = 0; r < 16; ++r) p1[r] = __builtin_amdgcn_exp2f(p1[r]);
  float ps = 0;
#pragma unroll
  for (int r = 0; r < 16; ++r) ps += p0[r];
#pragma unroll
  for (int r = 0; r < 16; ++r) ps += p1[r];
  { auto rr = __builtin_amdgcn_permlane32_swap(__float_as_uint(ps), __float_as_uint(ps), false, false);
    ps = __uint_as_float(rr[0]) + __uint_as_float(rr[1]); }
  l_reg = l_reg * alpha + ps;
#define PK4(P, BASE, OUT) do { unsigned a0 = cvtpk(P[BASE + 0], P[BASE + 1]), a1 = cvtpk(P[BASE + 2], P[BASE + 3]);   \
    unsigned b0 = cvtpk(P[BASE + 4], P[BASE + 5]), b1 = cvtpk(P[BASE + 6], P[BASE + 7]);                              \
    auto r0 = __builtin_amdgcn_permlane32_swap(a0, b0, false, false); auto r1 = __builtin_amdgcn_permlane32_swap(a1, b1, false, false); \
    u32x4 w = {r0[0], r1[0], r0[1], r1[1]}; OUT = *reinterpret_cast<bf16x8*>(&w); } while (0)
  PK4(p0, 0, pa0); PK4(p0, 8, pa1); PK4(p1, 0, pa2); PK4(p1, 8, pa3);
#undef PK4
}
__device__ __forceinline__ void qkt(f32x16& p0, f32x16& p1, const bf16* Ks, const bf16x8* qr, int r32, int hi) {
  p0 = f32x16{}; p1 = f32x16{};
#pragma unroll
  for (int d0 = 0; d0 < 8; ++d0) { int cb = (d0 * 16 + hi * 8) * 2;
    bf16x8 b0 = *reinterpret_cast<const bf16x8*>((const char*)Ks + KSWZ(r32, cb));
    bf16x8 b1 = *reinterpret_cast<const bf16x8*>((const char*)Ks + KSWZ(32 + r32, cb));
    p0 = __builtin_amdgcn_mfma_f32_32x32x16_bf16(b0, qr[d0], p0, 0, 0, 0);
    p1 = __builtin_amdgcn_mfma_f32_32x32x16_bf16(b1, qr[d0], p1, 0, 0, 0); }
}
__device__ __forceinline__ int v_st(int k, int c) { const int kk = (k & ~0xC) | ((k & 4) << 1) | ((k & 8) >> 1); return ((kk >> 3) * 4 + (c >> 5)) * 512 + ((kk & 7) * 32 + (c & 31)) * 2; }
__device__ __forceinline__ int v_rd_base(int lane) { return ((lane & 3) << 3) | (((lane >> 2) & 3) << 6) | (((lane >> 4) & 1) << 5) | (((lane >> 5) & 1) << 8); }
constexpr int v_rd_off(int d0, int ks, int half) { return d0 * 512 + ks * 4096 + half * 2048; }
template <int OFF> __device__ __forceinline__ s16x4 tr_read(int vb) {
  s16x4 r; asm volatile("ds_read_b64_tr_b16 %0, %1 offset:%2" : "=&v"(r) : "v"(vb), "i"(OFF) : "memory"); return r;
}
template <int D0> __device__ __forceinline__ void pv_one(f32x16& od, int vb, bf16x8 pa0, bf16x8 pa1, bf16x8 pa2, bf16x8 pa3) {
  const s16x4 l0 = tr_read<v_rd_off(D0, 0, 0)>(vb), h0 = tr_read<v_rd_off(D0, 0, 1)>(vb), l1 = tr_read<v_rd_off(D0, 1, 0)>(vb), h1 = tr_read<v_rd_off(D0, 1, 1)>(vb);
  const s16x4 l2 = tr_read<v_rd_off(D0, 2, 0)>(vb), h2 = tr_read<v_rd_off(D0, 2, 1)>(vb), l3 = tr_read<v_rd_off(D0, 3, 0)>(vb), h3 = tr_read<v_rd_off(D0, 3, 1)>(vb);
  asm volatile("s_waitcnt lgkmcnt(0)" ::: "memory"); SBAR();
#define PK(L, H) (bf16x8){L[0], L[1], L[2], L[3], H[0], H[1], H[2], H[3]}
  od = __builtin_amdgcn_mfma_f32_32x32x16_bf16(pa0, PK(l0, h0), od, 0, 0, 0);
  od = __builtin_amdgcn_mfma_f32_32x32x16_bf16(pa1, PK(l1, h1), od, 0, 0, 0);
  od = __builtin_amdgcn_mfma_f32_32x32x16_bf16(pa2, PK(l2, h2), od, 0, 0, 0);
  od = __builtin_amdgcn_mfma_f32_32x32x16_bf16(pa3, PK(l3, h3), od, 0, 0, 0);
#undef PK
}
__device__ __forceinline__ void pv_d0(f32x16* o, int vb, bf16x8 pa0, bf16x8 pa1, bf16x8 pa2, bf16x8 pa3) {
  pv_one<0>(o[0], vb, pa0, pa1, pa2, pa3); pv_one<1>(o[1], vb, pa0, pa1, pa2, pa3); pv_one<2>(o[2], vb, pa0, pa1, pa2, pa3); pv_one<3>(o[3], vb, pa0, pa1, pa2, pa3);
}
__device__ __forceinline__ void attn_dense_body(const bf16* __restrict__ Qb, const bf16* __restrict__ Kh, const bf16* __restrict__ Vh,
                                                float* __restrict__ Ob, int seq, char* lds, int tid) {
  asm volatile("" : "+v"(tid));
  const int wid = __builtin_amdgcn_readfirstlane(tid >> 6), lane = tid & 63, r32 = lane & 31, hi = lane >> 5;
  bf16* V_lds = (bf16*)lds; bf16* K_lds = (bf16*)(lds + 2 * SHM_V);
  float* ws = (float*)(lds + 2 * SHM_V + 2 * SHM_K) + wid * 64; float* li_l = ws; float* al_l = ws + 32;
  float m_reg = -1e30f, l_reg = 0; f32x16 o[4] = {}; bf16x8 qr[8];
  const bf16* Qw = Qb + (long)(wid * QBLK + r32) * LDQ + hi * 8;
#pragma unroll
  for (int d0 = 0; d0 < 8; ++d0) qr[d0] = ld8(Qw + d0 * 16);
  const int sr = tid >> 4, sc = (tid & 15) * 8, vst0 = v_st(sr, sc), vst1 = v_st(32 + sr, sc);
  const int vb0 = (int)(uintptr_t)V_lds + v_rd_base(lane);
  struct { bf16x8 vs0, vs1, ks0, ks1; } sr_[2];
#define SLOAD(i, k0) do { sr_[i].vs0 = ld8(&Vh[(long)((k0) + sr) * LDK + sc]); sr_[i].vs1 = ld8(&Vh[(long)((k0) + 32 + sr) * LDK + sc]); \
    sr_[i].ks0 = ld8(&Kh[(long)((k0) + sr) * LDK + sc]); sr_[i].ks1 = ld8(&Kh[(long)((k0) + 32 + sr) * LDK + sc]); } while (0)
#define SWRITE(b, i) do { *(bf16x8*)((char*)V_lds + (b) * SHM_V + vst0) = sr_[i].vs0;          \
    *(bf16x8*)((char*)V_lds + (b) * SHM_V + vst1) = sr_[i].vs1; int kc = sc * 2;               \
    *(bf16x8*)((char*)K_lds + (b) * SHM_K + KSWZ(sr, kc)) = sr_[i].ks0;                       \
    *(bf16x8*)((char*)K_lds + (b) * SHM_K + KSWZ(32 + sr, kc)) = sr_[i].ks1; } while (0)
#define SWAIT() asm volatile("s_waitcnt vmcnt(4)" ::: "memory")
#define RESC(a) do { if (__any((a) < 1.f)) { if (hi == 0) al_l[r32] = (a); asm volatile("s_waitcnt lgkmcnt(0)" ::: "memory"); \
    _Pragma("unroll") for (int d = 0; d < 4; ++d) _Pragma("unroll") for (int r = 0; r < 16; ++r) o[d][r] *= al_l[crow(r, hi)]; } } while (0)
  f32x16 pA0, pA1, pB0, pB1; float mnA, mnB, alA, alB; bf16x8 pa0, pa1, pa2, pa3; const int NT = seq / KVBLK;
  constexpr int SE = 0, SO = 1;
  SLOAD(SE, 0); asm volatile("s_waitcnt vmcnt(0)" ::: "memory"); SWRITE(0, SE); __syncthreads();
  qkt(pA0, pA1, K_lds, qr, r32, hi); partialSM(pA0, pA1, m_reg, mnA, alA);
  SLOAD(SO, KVBLK); if (2 < NT) SLOAD(SE, 2 * KVBLK);
  SWAIT(); SWRITE(1, SO); __syncthreads();
  for (int j = 1; j + 1 < NT; j += 2) {
    SBAR(); qkt(pB0, pB1, (bf16*)((char*)K_lds + SHM_K), qr, r32, hi);
    finishSM(pA0, pA1, alA, l_reg, pa0, pa1, pa2, pa3); SBAR();
    SLOAD(SO, (j + 2) * KVBLK); SBAR();
    pv_d0(o, vb0, pa0, pa1, pa2, pa3); partialSM(pB0, pB1, m_reg, mnB, alB);
    __syncthreads(); SWAIT(); SWRITE(0, SE);
    RESC(alB); __syncthreads();
    SBAR(); qkt(pA0, pA1, K_lds, qr, r32, hi);
    finishSM(pB0, pB1, alB, l_reg, pa0, pa1, pa2, pa3); SBAR();
    if (j + 3 < NT) SLOAD(SE, (j + 3) * KVBLK); SBAR();
    pv_d0(o, vb0 + (int)SHM_V, pa0, pa1, pa2, pa3); partialSM(pA0, pA1, m_reg, mnA, alA);
    __syncthreads(); SWAIT(); SWRITE(1, SO);
    RESC(alA); __syncthreads();
  }
  SBAR(); qkt(pB0, pB1, (bf16*)((char*)K_lds + SHM_K), qr, r32, hi);
  finishSM(pA0, pA1, alA, l_reg, pa0, pa1, pa2, pa3); SBAR();
  pv_d0(o, vb0, pa0, pa1, pa2, pa3); partialSM(pB0, pB1, m_reg, mnB, alB);
  __syncthreads(); RESC(alB);
  finishSM(pB0, pB1, alB, l_reg, pa0, pa1, pa2, pa3); SBAR();
  pv_d0(o, vb0 + (int)SHM_V, pa0, pa1, pa2, pa3);
  if (hi == 0) li_l[r32] = l_reg; asm volatile("s_waitcnt lgkmcnt(0)" ::: "memory");
  float rli[16];
#pragma unroll
  for (int r = 0; r < 16; ++r) rli[r] = __builtin_amdgcn_rcpf(li_l[crow(r, hi)]);
  float* Ow = Ob + (long)(wid * QBLK) * LDO;
#pragma unroll
  for (int r = 0; r < 16; ++r) { int orow = crow(r, hi);
#pragma unroll
    for (int d0 = 0; d0 < 4; ++d0) Ow[(long)orow * LDO + d0 * 32 + r32] = o[d0][r] * rli[r]; }
  __syncthreads();
#undef SLOAD
#undef SWRITE
#undef SWAIT
#undef RESC
}

constexpr int K8_BYTES = KVBLK * D * 2;
template <int ND> constexpr int v_rd_offn(int d0, int ks, int half) { return ((2 * ks + half) * ND + d0) * 512; }
template <int ND, int D0> __device__ __forceinline__ void pv_onen(f32x16& od, int vb, bf16x8 pa0, bf16x8 pa1, bf16x8 pa2, bf16x8 pa3) {
  const s16x4 l0 = tr_read<v_rd_offn<ND>(D0, 0, 0)>(vb), h0 = tr_read<v_rd_offn<ND>(D0, 0, 1)>(vb), l1 = tr_read<v_rd_offn<ND>(D0, 1, 0)>(vb), h1 = tr_read<v_rd_offn<ND>(D0, 1, 1)>(vb);
  const s16x4 l2 = tr_read<v_rd_offn<ND>(D0, 2, 0)>(vb), h2 = tr_read<v_rd_offn<ND>(D0, 2, 1)>(vb), l3 = tr_read<v_rd_offn<ND>(D0, 3, 0)>(vb), h3 = tr_read<v_rd_offn<ND>(D0, 3, 1)>(vb);
  asm volatile("s_waitcnt lgkmcnt(0)" ::: "memory"); SBAR();
#define PK(L, H) (bf16x8){L[0], L[1], L[2], L[3], H[0], H[1], H[2], H[3]}
  od = __builtin_amdgcn_mfma_f32_32x32x16_bf16(pa0, PK(l0, h0), od, 0, 0, 0);
  od = __builtin_amdgcn_mfma_f32_32x32x16_bf16(pa1, PK(l1, h1), od, 0, 0, 0);
  od = __builtin_amdgcn_mfma_f32_32x32x16_bf16(pa2, PK(l2, h2), od, 0, 0, 0);
  od = __builtin_amdgcn_mfma_f32_32x32x16_bf16(pa3, PK(l3, h3), od, 0, 0, 0);
#undef PK
}
template <int ND, class Side>
__device__ __forceinline__ void attn_dma_body(const bf16* __restrict__ Qb, const bf16* __restrict__ Kh, const bf16* __restrict__ Vh,
                                              float* __restrict__ Ob, int seq, LAS unsigned char* lds3, int tid, const Side& side) {
  constexpr int VB = KVBLK * ND * 32 * 2;
  asm volatile("" : "+v"(tid));
  const int wid = __builtin_amdgcn_readfirstlane(tid >> 6), lane = tid & 63, r32 = lane & 31, hi = lane >> 5;
  char* lds = (char*)lds3;
  bf16* K_lds = (bf16*)lds;
  float* ws = (float*)(lds + 3 * K8_BYTES + 3 * VB) + wid * 64; float* li_l = ws; float* al_l = ws + 32;
  float m_reg = -1e30f, l_reg = 0; f32x16 o[ND] = {}; bf16x8 qr[8];
  const bf16* Qw = Qb + (long)(wid * QBLK + r32) * LDQ + hi * 8;
#pragma unroll
  for (int d0 = 0; d0 < 8; ++d0) qr[d0] = ld8(Qw + d0 * 16);
  unsigned koff[2];
#pragma unroll
  for (int i = 0; i < 2; ++i) { const int row = 4 * (2 * wid + i) + (lane >> 4), lc = (lane & 15) ^ (row & 7); koff[i] = (unsigned)(row * LDK + lc * 8) * 2u; }
  unsigned voff;
  { const int kk = 8 * wid + ((lane & 31) >> 2), k = (kk & ~0xC) | ((kk & 4) << 1) | ((kk & 8) >> 1);
    voff = (unsigned)(k * LDK + (lane >> 5) * 32 + (lane & 3) * 8) * 2u; }
  const int vb0 = (int)(uintptr_t)(lds + 3 * K8_BYTES) + v_rd_base(lane);
#define DMA_TILE(t, b) do { const size_t go_ = (size_t)(t) * KVBLK * LDK * 2; const char* kb_ = (const char*)Kh + go_; const char* vb_ = (const char*)Vh + go_; \
    _Pragma("unroll") for (int i_ = 0; i_ < 2; ++i_) __builtin_amdgcn_global_load_lds((const unsigned*)(kb_ + koff[i_]), (LAS unsigned*)(lds3 + (b) * K8_BYTES + (2 * wid + i_) * 1024), 16, 0, 0); \
    _Pragma("unroll") for (int i_ = 0; i_ < ND / 2; ++i_) __builtin_amdgcn_global_load_lds((const unsigned*)(vb_ + i_ * 128 + voff), (LAS unsigned*)(lds3 + 3 * K8_BYTES + (b) * VB + ((ND / 2) * wid + i_) * 1024), 16, 0, 0); } while (0)
#define RESCN(a) do { if (__any((a) < 1.f)) { if (hi == 0) al_l[r32] = (a); asm volatile("s_waitcnt lgkmcnt(0)" ::: "memory"); \
    _Pragma("unroll") for (int d = 0; d < ND; ++d) _Pragma("unroll") for (int r = 0; r < 16; ++r) o[d][r] *= al_l[crow(r, hi)]; } } while (0)
  const int NT = seq / KVBLK;
  DMA_TILE(0, 0); DMA_TILE(1, 1);
  asm volatile("s_waitcnt vmcnt(0)" ::: "memory"); __syncthreads();
  int b = 0, bn2 = 2;
  float sv[8]; bf16_t* sdst = nullptr; bool shave = false;
  for (int j = 0; j < NT; ++j) {
    f32x16 p0, p1; float mn, al; bf16x8 pa0, pa1, pa2, pa3;
    SBAR(); qkt(p0, p1, (bf16*)((char*)K_lds + b * K8_BYTES), qr, r32, hi); SBAR();
    asm volatile("s_waitcnt vmcnt(0)" ::: "memory");
    if (shave) side.finish(sv, sdst);
    { const float* ssrc; int sld; shave = side.addr(j, lane, ssrc, sld, sdst); if (shave) cvt_load8(sv, ssrc, sld); }
    if (j + 2 < NT) DMA_TILE(j + 2, bn2);
    partialSM(p0, p1, m_reg, mn, al);
    RESCN(al);
    finishSM(p0, p1, al, l_reg, pa0, pa1, pa2, pa3); SBAR();
    { const int vb = vb0 + b * VB;
      pv_onen<ND, 0>(o[0], vb, pa0, pa1, pa2, pa3); pv_onen<ND, 1>(o[1], vb, pa0, pa1, pa2, pa3); pv_onen<ND, 2>(o[2], vb, pa0, pa1, pa2, pa3); pv_onen<ND, 3>(o[3], vb, pa0, pa1, pa2, pa3);
      if constexpr (ND == 8) { pv_onen<ND, 4>(o[4], vb, pa0, pa1, pa2, pa3); pv_onen<ND, 5>(o[5], vb, pa0, pa1, pa2, pa3); pv_onen<ND, 6>(o[6], vb, pa0, pa1, pa2, pa3); pv_onen<ND, 7>(o[7], vb, pa0, pa1, pa2, pa3); } }
    asm volatile("s_waitcnt lgkmcnt(0)\n\ts_barrier" ::: "memory");
    bn2 = b; b = (b == 2) ? 0 : b + 1;
  }
  if (shave) { asm volatile("s_waitcnt vmcnt(0)" ::: "memory"); side.finish(sv, sdst); }
  if (hi == 0) li_l[r32] = l_reg; asm volatile("s_waitcnt lgkmcnt(0)" ::: "memory");
  float rli[16];
#pragma unroll
  for (int r = 0; r < 16; ++r) rli[r] = __builtin_amdgcn_rcpf(li_l[crow(r, hi)]);
  float* Ow = Ob + (long)(wid * QBLK) * LDO;
#pragma unroll
  for (int r = 0; r < 16; ++r) { int orow = crow(r, hi);
#pragma unroll
    for (int d0 = 0; d0 < ND; ++d0) Ow[(long)orow * LDO + d0 * 32 + r32] = o[d0][r] * rli[r]; }
  __syncthreads();
#undef DMA_TILE
#undef RESCN
}
#undef SBAR
}

struct Args { const float* in[29]; float* out; unsigned char* ws; int ph_lo, ph_hi, one_launch, pad; };
typedef const __attribute__((address_space(4))) Args* KArgs;
struct Frame {
    LAS unsigned char* lds;
    volatile LAS unsigned* MISC;
    unsigned* ctl;
    int tid, lane, wave, vcu, G;
    KArgs ap;
    float* out; unsigned char* ws;
};
#define INP(i) (F.ap->in[i])
#define RELAUNDER() do { asm volatile("" : "+s"(F.ap)); F.lane = lane_id_v(); F.tid = F.wave * 64 + F.lane; } while (0)
enum { I_X = 0, I_C, I_CTX, I_CCTX, I_WADA, I_BADA, I_NMIX, I_NFFN, I_WIN, I_QNA, I_KNA, I_QNB, I_KNB, I_LQ1, I_LK1, I_LQ2, I_LK2, I_SUBLN, I_WA, I_WB, I_WO, I_WR, I_RB, I_WEG, I_WEU, I_WED, I_WSG, I_WSU, I_WSD };

__device__ __forceinline__ f32x4 load_mod4(const Frame& F, int v, int j, int k) {
    return *(const f32x4*)((const float*)(F.ws + WS_MOD) + (size_t)v * (NMOD * DM) + j * DM + k);
}

__device__ __forceinline__ void cvt_load8(float (&v)[8], const float* src, int ld) {
#pragma unroll
    for (int j = 0; j < 8; ++j) v[j] = __builtin_nontemporal_load(src + (size_t)j * ld);
}
__device__ __forceinline__ void cvt_store8(const float (&v)[8], bf16_t* dst) {
    u32x4 o; o.x = pk2(v[0], v[1]); o.y = pk2(v[2], v[3]); o.z = pk2(v[4], v[5]); o.w = pk2(v[6], v[7]);
    __builtin_nontemporal_store(o, (u32x4*)dst);
}
constexpr int XJ_PER = 2048, XJ_TOTAL = 3 * 65 * XJ_PER;
__device__ __forceinline__ void xjob_decode(const Frame& F, int J, int lane, const float*& src, int& ld, bf16_t*& dst) {
    const int type = J / (65 * XJ_PER), r = J - type * (65 * XJ_PER), e = r / XJ_PER, q = r % XJ_PER;
    if (type < 2) { const int kc = q >> 3, n = (q & 7) * 64 + lane;
        const float* base = (e < 64) ? INP(type ? I_WEU : I_WEG) + (size_t)e * DM * FE : INP(type ? I_WSU : I_WSG);
        src = base + (size_t)(8 * kc) * FE + n; ld = FE;
        const int np = (n >> 7) * 256 + type * 128 + (n & 127);
        dst = (bf16_t*)(F.ws + WS_WGU + (size_t)e * GU_BYTES) + ((size_t)kc * NP_GU + np) * 8;
    } else { const int kc = q >> 5, n = (q & 31) * 64 + lane;
        const float* base = (e < 64) ? INP(I_WED) + (size_t)e * FE * DM : INP(I_WSD);
        src = base + (size_t)(8 * kc) * DM + n; ld = DM;
        dst = (bf16_t*)(F.ws + WS_WD + (size_t)e * D_BYTES) + ((size_t)kc * NP_D + n) * 8;
    }
}

struct NoSide { __device__ __forceinline__ bool addr(int, int, const float*&, int&, bf16_t*&) const { return false; }
                __device__ __forceinline__ void finish(const float (&)[8], bf16_t*) const {} };
struct XcvtSide { const Frame* F; int step0;
    __device__ __forceinline__ bool addr(int j, int lane, const float*& src, int& ld, bf16_t*& dst) const {
        const int J = ((step0 + j) * F->G + F->vcu) * NWAVES + F->wave; if (J >= XJ_TOTAL) return false;
        xjob_decode(*F, J, lane, src, ld, dst); return true; }
    __device__ __forceinline__ void finish(const float (&v)[8], bf16_t* dst) const { cvt_store8(v, dst); } };

__device__ __forceinline__ void p0_prologue(Frame& F) {
    const int gw = F.vcu * NWAVES + F.wave, NGW = F.G * NWAVES;
    bf16_t* Win = (bf16_t*)(F.ws + WS_WIN); bf16_t* Wab = (bf16_t*)(F.ws + WS_WAB); bf16_t* Wo = (bf16_t*)(F.ws + WS_WO);
    constexpr int J_IN = 256 * (INW / 64), J_AB = 256 * (DM / 64), J_O = 256 * (DM / 64), NJ = J_IN + J_AB + J_O;
#if !P0_EXPERTS
    constexpr int NJ_ALL = NJ;
#else
    constexpr int NJ_ALL = NJ + XJ_TOTAL;
#endif
    for (int it = gw; it < NJ_ALL; it += 2 * NGW) {
        const float* src[2]; int ld[2]; bf16_t* dst[2]; bool ok[2];
#pragma unroll
        for (int h = 0; h < 2; ++h) { int r = it + h * NGW; ok[h] = r < NJ_ALL; if (!ok[h]) r = it;
            if (r < J_IN) { const int kc = r / (INW / 64), n = (r % (INW / 64)) * 64 + F.lane; const int nsrc = is_qk_col(n) ? (n & ~127) + rope_e(n & 127) : n;
                src[h] = INP(I_WIN) + (size_t)(8 * kc) * INW + nsrc; ld[h] = INW; dst[h] = Win + ((size_t)kc * INW + n) * 8; }
            else if (r < J_IN + J_AB) { r -= J_IN; const int kc = r >> 5, n = (r & 31) * 64 + F.lane;
                src[h] = (kc < 128 ? INP(I_WA) + (size_t)(8 * kc) * DM : INP(I_WB) + (size_t)(8 * (kc - 128)) * DM) + n; ld[h] = DM; dst[h] = Wab + ((size_t)kc * DM + n) * 8; }
            else if (r < NJ) { r -= J_IN + J_AB; const int kc = r >> 5, n = (r & 31) * 64 + F.lane; src[h] = INP(I_WO) + (size_t)(8 * kc) * DM + n; ld[h] = DM; dst[h] = Wo + ((size_t)kc * DM + n) * 8; }
            else { xjob_decode(F, r - NJ, F.lane, src[h], ld[h], dst[h]); } }
        float v0[8], v1[8]; cvt_load8(v0, src[0], ld[0]); cvt_load8(v1, src[1], ld[1]);
        cvt_store8(v0, dst[0]); if (ok[1]) cvt_store8(v1, dst[1]);
    }
    { bf16_t* whi = (bf16_t*)(F.ws + WS_WRHI); bf16_t* wlo = (bf16_t*)(F.ws + WS_WRLO);
      for (int idx = (F.vcu * NTHREADS + F.tid); idx < DM * NE; idx += F.G * NTHREADS) { const int k = idx >> 6, n = idx & 63;
          const float w = INP(I_WR)[idx]; const unsigned h = f2bf(w); const float rem = w - __uint_as_float(h << 16);
          whi[n * DM + k] = (bf16_t)h; wlo[n * DM + k] = (bf16_t)f2bf(rem); } }
    { f32x2* cs = (f32x2*)(F.ws + WS_CS);
      for (int idx = (F.vcu * NTHREADS + F.tid); idx < SEQ * 64; idx += F.G * NTHREADS) { const int t = idx >> 6, pi = idx & 63, i = pi & 31;
          const float inv = exp2f(-(float)i * (13.287712379549449f / 32.0f)); const float pos = (pi < 32) ? (float)(t >> 6) : (float)(t & 63); const float a = pos * inv;
          cs[idx] = (f32x2){cosf(a), sinf(a)}; } }
    __syncthreads();
    if (blockIdx.x < 192) {
        const int cb = blockIdx.x % 48, kq = blockIdx.x / 48;
        const float* wada = INP(I_WADA) + cb * 256 + 4 * F.lane;
        const int kbase = kq * 512 + F.wave * 64;
        f32x4 a0 = {0.f, 0.f, 0.f, 0.f}, a1 = {0.f, 0.f, 0.f, 0.f};
#pragma unroll 8
        for (int j = 0; j < 64; ++j) { const int k = kbase + j;
            const float c0 = INP(I_C)[k], c1 = INP(I_CCTX)[k];
            const float s0 = c0 * sigmoidf_(c0), s1 = c1 * sigmoidf_(c1);
            const f32x4 w = *(const f32x4*)(wada + (size_t)k * (NMOD * DM));
            a0 = a0 + w * s0; a1 = a1 + w * s1; }
        LAS f32x4* red = (LAS f32x4*)F.lds;
        red[(F.wave * 2 + 0) * 64 + F.lane] = a0; red[(F.wave * 2 + 1) * 64 + F.lane] = a1;
        LDS_WAIT(); __syncthreads();
        { const int v = F.tid >> 8, col = F.tid & 255; const LAS float* rf = (const LAS float*)F.lds; float s = 0.f;
#pragma unroll
          for (int w = 0; w < 8; ++w) s += rf[((w * 2 + v) * 64 + (col >> 2)) * 4 + (col & 3)];
          float* modp = (float*)(F.ws + WS_MODP);
          modp[(size_t)(kq * 2 + v) * (NMOD * DM) + cb * 256 + col] = s; }
        __threadfence(); __syncthreads();
        LAS unsigned* flg = (LAS unsigned*)(F.lds + 32768);
        if (F.tid == 0) { const unsigned old = __hip_atomic_fetch_add(F.ctl + CW_ADA + cb, 1u, __ATOMIC_ACQ_REL, __HIP_MEMORY_SCOPE_AGENT); flg[0] = (old == 3u) ? 1u : 0u; }
        LDS_WAIT(); __syncthreads();
        if (flg[0]) { __threadfence();
            const int v = F.tid >> 8, col = cb * 256 + (F.tid & 255); const float* modp = (const float*)(F.ws + WS_MODP);
            float s = INP(I_BADA)[col];
#pragma unroll
            for (int q = 0; q < 4; ++q) s += __hip_atomic_load(modp + (size_t)(q * 2 + v) * (NMOD * DM) + col, __ATOMIC_RELAXED, __HIP_MEMORY_SCOPE_AGENT);
            ((float*)(F.ws + WS_MOD))[(size_t)v * (NMOD * DM) + col] = s; }
        __syncthreads();
    }
}

template <bool SPLIT>
__device__ __forceinline__ void norm_mod_rows(Frame& F, int rbeg, int rend, int rstep, const float* gain, int jshift, bf16_t* ohi, bf16_t* olo, bool ctx_first) {
    f32x4 Am[8], Bm[8]; int curv = -1;
    for (int r = rbeg; r < rend; r += rstep) {
        const int v = (ctx_first && r < CTXL) ? 1 : 0;
        if (v != curv) { curv = v;
#pragma unroll
            for (int j = 0; j < 8; ++j) { const int k = 4 * F.lane + 256 * j; const f32x4 g = *(const f32x4*)(gain + k);
                const f32x4 sh = load_mod4(F, v, jshift, k), sc = load_mod4(F, v, jshift + 1, k);
                Am[j] = g * (sc + 1.0f); Bm[j] = sh; } }
        const float* src = ctx_first ? (r < CTXL ? INP(I_CTX) + (size_t)r * DM : INP(I_X) + (size_t)(r - CTXL) * DM) : (const float*)(F.ws + WS_X1) + (size_t)r * DM;
        f32x4 x[8]; float ss = 0.f;
#pragma unroll
        for (int j = 0; j < 8; ++j) { x[j] = *(const f32x4*)(src + 4 * F.lane + 256 * j); ss += (x[j][0] * x[j][0] + x[j][1] * x[j][1]) + (x[j][2] * x[j][2] + x[j][3] * x[j][3]); }
        const float rstd = 1.0f / sqrtf(wave_sum(ss) * (1.0f / DM) + EPS);
#pragma unroll
        for (int j = 0; j < 8; ++j) { const f32x4 h = (x[j] * rstd) * Am[j] + Bm[j];
            const unsigned w0 = pk2(h[0], h[1]), w1 = pk2(h[2], h[3]);
            u32x2 o; o.x = w0; o.y = w1; *(u32x2*)(ohi + (size_t)r * DM + 4 * F.lane + 256 * j) = o;
            if (SPLIT) { u32x2 l; l.x = pk2(h[0] - bflo(w0), h[1] - bfhi(w0)); l.y = pk2(h[2] - bflo(w1), h[3] - bfhi(w1)); *(u32x2*)(olo + (size_t)r * DM + 4 * F.lane + 256 * j) = l; } }
    }
}

__device__ __forceinline__ void p3_headnorm_rope(Frame& F) {
    const int gw = F.vcu * NWAVES + F.wave, NGW = F.G * NWAVES;
    bf16_t* P = (bf16_t*)(F.ws + WS_P);
    const int e0 = 2 * F.lane;
    const int i0 = e0 & 31;
    const float inv0 = exp2f(-(float)i0 * (13.287712379549449f / 32.0f)), inv1 = exp2f(-(float)(i0 + 1) * (13.287712379549449f / 32.0f));
    const bool second = (F.lane & 16) != 0;
    const f32x2 gq_a = *(const f32x2*)(INP(I_QNA) + e0), gk_a = *(const f32x2*)(INP(I_KNA) + e0), gq_b = *(const f32x2*)(INP(I_QNB) + e0), gk_b = *(const f32x2*)(INP(I_KNB) + e0);
#define P3_COL(hh) ((hh) < 8 ? C_AQ + (hh) * 128 : (hh) < 10 ? C_AK + ((hh) - 8) * 128 : (hh) < 18 ? C_BQ + ((hh) - 10) * 128 : C_BK + ((hh) - 18) * 128)
#define P3_ISQ(hh) ((hh) < 8 || ((hh) >= 10 && (hh) < 18))
    for (int r = gw; r < MT; r += NGW) {
        const bool lat = r >= CTXL;
        float c0 = 1.f, s0 = 0.f, c1 = 1.f, s1 = 0.f;
        if (lat) { const int t = r - CTXL; const float pos = (F.lane < 32) ? (float)(t >> 6) : (float)(t & 63);
            const float a0 = pos * inv0, a1 = pos * inv1; c0 = cosf(a0); s0 = sinf(a0); c1 = cosf(a1); s1 = sinf(a1); }
        unsigned* prow = (unsigned*)(P + (size_t)r * INW + e0);
        unsigned w[26];
#pragma unroll
        for (int hh = 0; hh < 26; ++hh) { w[hh] = 0u; if (lat || !P3_ISQ(hh)) w[hh] = prow[P3_COL(hh) / 2]; }
#pragma unroll
        for (int hh = 0; hh < 26; ++hh) {
            if (!lat && P3_ISQ(hh)) continue;
            const f32x2 g = hh < 8 ? gq_a : hh < 10 ? gk_a : hh < 18 ? gq_b : gk_b;
            float x0 = bflo(w[hh]), x1 = bfhi(w[hh]);
            const float ss = wave_sum(x0 * x0 + x1 * x1);
            const float rstd = 1.0f / sqrtf(ss * (1.0f / 128.0f) + EPS);
            x0 = x0 * rstd * g[0]; x1 = x1 * rstd * g[1];
            if (lat) { const float y0 = __shfl_xor(x0, 16), y1 = __shfl_xor(x1, 16);
                if (!second) { x0 = x0 * c0 - y0 * s0; x1 = x1 * c1 - y1 * s1; } else { x0 = y0 * s0 + x0 * c0; x1 = y1 * s1 + x1 * c1; } }
            prow[P3_COL(hh) / 2] = pk2(x0, x1);
        }
    }
#undef P3_COL
#undef P3_ISQ
}

__device__ __forceinline__ void p5_combine(Frame& F) {
    const int gw = F.vcu * NWAVES + F.wave, NGW = F.G * NWAVES;
    float d1 = INP(I_LQ1)[F.lane] * INP(I_LK1)[F.lane] + INP(I_LQ1)[F.lane + 64] * INP(I_LK1)[F.lane + 64];
    float d2 = INP(I_LQ2)[F.lane] * INP(I_LK2)[F.lane] + INP(I_LQ2)[F.lane + 64] * INP(I_LK2)[F.lane + 64];
    d1 = wave_sum(d1); d2 = wave_sum(d2);
    const float lam_init = 0.2f;
    const float lam = expf(d1) - expf(d2) + lam_init;
    const float* OA = (const float*)(F.ws + WS_OA); const float* OB0 = (const float*)(F.ws + WS_OB0); const float* OB1 = (const float*)(F.ws + WS_OB1);
    bf16_t* A2 = (bf16_t*)(F.ws + WS_A2);
    const f32x4 sg = *(const f32x4*)(INP(I_SUBLN) + 4 * F.lane);
    for (int t = gw; t < SEQ; t += NGW) {
#pragma unroll
        for (int j = 0; j < 4; ++j) { const f32x4 a = *(const f32x4*)(OA + (size_t)t * 1024 + 4 * F.lane + 256 * j);
            u32x2 o; o.x = pk2(a[0], a[1]); o.y = pk2(a[2], a[3]); *(u32x2*)(A2 + (size_t)t * DM + 4 * F.lane + 256 * j) = o; }
#pragma unroll
        for (int h = 0; h < 4; ++h) { const f32x4 u0 = *(const f32x4*)(OB0 + (size_t)t * 1024 + h * 256 + 4 * F.lane), u1 = *(const f32x4*)(OB1 + (size_t)t * 1024 + h * 256 + 4 * F.lane);
            const f32x4 d = u0 - u1 * lam;
            const float ss = wave_sum((d[0] * d[0] + d[1] * d[1]) + (d[2] * d[2] + d[3] * d[3]));
            const float rstd = 1.0f / sqrtf(ss * (1.0f / 256.0f) + EPS);
            const f32x4 y = (d * rstd) * sg * (1.0f - lam_init);
            u32x2 o; o.x = pk2(y[0], y[1]); o.y = pk2(y[2], y[3]); *(u32x2*)(A2 + (size_t)t * DM + 1024 + h * 256 + 4 * F.lane) = o; }
    }
}

__device__ __forceinline__ void p10_router(Frame& F) {
    const bf16_t* Hhi = (const bf16_t*)(F.ws + WS_H2HI); const bf16_t* Hlo = (const bf16_t*)(F.ws + WS_H2LO);
    const bf16_t* Whi = (const bf16_t*)(F.ws + WS_WRHI); const bf16_t* Wlo = (const bf16_t*)(F.ws + WS_WRLO);
    int* tokE = (int*)(F.ws + WS_TOKE); int* tokS = (int*)(F.ws + WS_TOKS); float* tokW = (float*)(F.ws + WS_TOKW); int* list = (int*)(F.ws + WS_LIST);
    unsigned* cnt = F.ctl + CW_CNT;
    LAS float* part = (LAS float*)F.lds;
    LAS float* logit = (LAS float*)(F.lds + 65536);
    LAS float* score = (LAS float*)(F.lds + 65536 + 32 * 65 * 4);
    const int r32 = F.lane & 31, hi = F.lane >> 5;
    for (int u = F.vcu; u < SEQ / 32; u += F.G) {
        const int row0 = u * 32;
        norm_mod_rows<true>(F, row0 + F.wave * 4, row0 + F.wave * 4 + 4, 1, INP(I_NFFN), 3, (bf16_t*)(F.ws + WS_H2HI), (bf16_t*)(F.ws + WS_H2LO), false);
        VM_WAIT(); __syncthreads(); __builtin_amdgcn_fence(__ATOMIC_ACQUIRE, "agent"); VM_WAIT();
        f32x16 acc0 = {}, acc1 = {};
        const int kb = F.wave * 256 + hi * 8;
#pragma unroll 4
        for (int s = 0; s < 16; ++s) { const int k = kb + 16 * s;
            const bf16x8 ah = *(const bf16x8*)(Hhi + (size_t)(row0 + r32) * DM + k), al = *(const bf16x8*)(Hlo + (size_t)(row0 + r32) * DM + k);
            const bf16x8 b0h = *(const bf16x8*)(Whi + (size_t)r32 * DM + k), b0l = *(const bf16x8*)(Wlo + (size_t)r32 * DM + k);
            const bf16x8 b1h = *(const bf16x8*)(Whi + (size_t)(32 + r32) * DM + k), b1l = *(const bf16x8*)(Wlo + (size_t)(32 + r32) * DM + k);
            acc0 = __builtin_amdgcn_mfma_f32_32x32x16_bf16(al, b0h, acc0, 0, 0, 0); acc0 = __builtin_amdgcn_mfma_f32_32x32x16_bf16(ah, b0l, acc0, 0, 0, 0); acc0 = __builtin_amdgcn_mfma_f32_32x32x16_bf16(ah, b0h, acc0, 0, 0, 0);
            acc1 = __builtin_amdgcn_mfma_f32_32x32x16_bf16(al, b1h, acc1, 0, 0, 0); acc1 = __builtin_amdgcn_mfma_f32_32x32x16_bf16(ah, b1l, acc1, 0, 0, 0); acc1 = __builtin_amdgcn_mfma_f32_32x32x16_bf16(ah, b1h, acc1, 0, 0, 0); }
#pragma unroll
        for (int r = 0; r < 16; ++r) { const int row = attn::crow(r, hi); part[(F.wave * 32 + row) * 64 + r32] = acc0[r]; part[(F.wave * 32 + row) * 64 + 32 + r32] = acc1[r]; }
        LDS_WAIT(); __syncthreads();
        {
            const int row = F.tid >> 4, q = F.tid & 15, e4 = q * 4, t = row0 + row; f32x4 s = {0.f, 0.f, 0.f, 0.f};
#pragma unroll
            for (int w = 0; w < 8; ++w) s = s + *(const LAS f32x4*)(part + (w * 32 + row) * 64 + e4);
            LAS float* bs = logit + row * 65;
            float sc[4], bv[4];
#pragma unroll
            for (int j = 0; j < 4; ++j) { sc[j] = sigmoidf_(s[j]); bv[j] = sc[j] + INP(I_RB)[e4 + j]; bs[e4 + j] = bv[j]; }
            float m1 = fmaxf(bv[0], bv[1]), m2 = fminf(bv[0], bv[1]);
            { const float a = fmaxf(bv[2], bv[3]), b = fminf(bv[2], bv[3]); const float n1 = fmaxf(m1, a); m2 = fmaxf(fminf(m1, a), fmaxf(m2, b)); m1 = n1; }
            { const float p1 = __shfl_xor(m1, 1), p2 = __shfl_xor(m2, 1); const float n1 = fmaxf(m1, p1); m2 = fmaxf(fminf(m1, p1), fmaxf(m2, p2)); m1 = n1; }
            const float gs = m1 + m2;
            float gsv[8];
#pragma unroll
            for (int g = 0; g < 8; ++g) gsv[g] = __shfl(gs, (F.lane & 48) + 2 * g);
            unsigned gmask = 0u;
#pragma unroll
            for (int g = 0; g < 8; ++g) { int rk = 0;
#pragma unroll
                for (int h = 0; h < 8; ++h) rk += (gsv[h] > gsv[g] || (gsv[h] == gsv[g] && h < g)) ? 1 : 0;
                gmask |= (rk < 4) ? (1u << g) : 0u; }
            LDS_WAIT(); __syncthreads();
            const bool mysel = (gmask >> (q >> 1)) & 1u;
            int rk[4] = {0, 0, 0, 0};
            if (mysel) {
                for (int e = 0; e < 64; ++e) { if (!((gmask >> (e >> 3)) & 1u)) continue; const float v = bs[e];
#pragma unroll
                    for (int j = 0; j < 4; ++j) rk[j] += (v > bv[j] || (v == bv[j] && e < e4 + j)) ? 1 : 0; } }
            float ssum = 0.f;
#pragma unroll
            for (int j = 0; j < 4; ++j) ssum += (mysel && rk[j] < 8) ? sc[j] : 0.f;
            ssum += __shfl_xor(ssum, 1); ssum += __shfl_xor(ssum, 2); ssum += __shfl_xor(ssum, 4); ssum += __shfl_xor(ssum, 8);
            const float inv = 2.5f / ssum;
#pragma unroll
            for (int j = 0; j < 4; ++j) if (mysel && rk[j] < 8) { const int e = e4 + j, k = rk[j];
                const unsigned slot = __hip_atomic_fetch_add(cnt + e, 1u, RLX_AGENT);
                list[e * SEQ + (int)slot] = t; tokE[t * 8 + k] = e; tokS[t * 8 + k] = (int)slot; tokW[t * 8 + k] = sc[j] * inv; }
        }
        __syncthreads();
    }
}

__device__ __forceinline__ void moe_tables(Frame& F) {
    LAS int* tab = (LAS int*)(F.lds + TAB_OFF);
    __syncthreads();
    if (F.tid == 0) { int off = 0;
        for (int e = 0; e < 64; ++e) { int c = (int)__hip_atomic_load(F.ctl + CW_CNT + e, RLX_AGENT); c = c < 0 ? 0 : (c > SEQ ? SEQ : c); tab[e] = c; tab[65 + e] = off; off += (c + 255) >> 8; }
        if (off > SH_TILE0) off = SH_TILE0;
        tab[64] = SEQ; tab[65 + 64] = off; tab[65 + 65] = off + 32; }
    LDS_WAIT(); __syncthreads();
}

__device__ __forceinline__ void fp8x16_fma(f32x4 (&a)[4], const u32x4 w, float sc) {
#pragma unroll
    for (int q = 0; q < 4; ++q) { const int x = (int)w[q];
        a[q][0] += sc * __builtin_amdgcn_cvt_f32_fp8(x, 0); a[q][1] += sc * __builtin_amdgcn_cvt_f32_fp8(x, 1); a[q][2] += sc * __builtin_amdgcn_cvt_f32_fp8(x, 2); a[q][3] += sc * __builtin_amdgcn_cvt_f32_fp8(x, 3); }
}
__device__ __forceinline__ void p13_final(Frame& F) {
    const int gw = F.vcu * NWAVES + F.wave, NGW = F.G * NWAVES;
    const LAS int* toff = (const LAS int*)(F.lds + TAB_OFF) + 65;
    const int* tokE = (const int*)(F.ws + WS_TOKE); const int* tokS = (const int*)(F.ws + WS_TOKS); const float* tokW = (const float*)(F.ws + WS_TOKW);
    const unsigned char* Y = (const unsigned char*)(F.ws + WS_YROWS); const float* X1 = (const float*)(F.ws + WS_X1);
    f32x4 g5[2][4];
#pragma unroll
    for (int j = 0; j < 2; ++j)
#pragma unroll
        for (int q = 0; q < 4; ++q) g5[j][q] = load_mod4(F, 0, 5, 16 * F.lane + 1024 * j + 4 * q);
    for (int t = gw; t < SEQ; t += NGW) {
        f32x4 a[2][4];
#pragma unroll
        for (int j = 0; j < 2; ++j)
#pragma unroll
            for (int q = 0; q < 4; ++q) a[j][q] = (f32x4){0.f, 0.f, 0.f, 0.f};
        { const unsigned char* yr = Y + ((size_t)SH_TILE0 * 256 + t) * DM + 16 * F.lane;
#pragma unroll
          for (int j = 0; j < 2; ++j) fp8x16_fma(a[j], *(const u32x4*)(yr + 1024 * j), 1.0f / 32.0f); }
#pragma unroll
        for (int k = 0; k < 8; ++k) {
            const int e = __builtin_amdgcn_readfirstlane(tokE[t * 8 + k]), sl = __builtin_amdgcn_readfirstlane(tokS[t * 8 + k]);
            const float wk = __uint_as_float(__builtin_amdgcn_readfirstlane(__float_as_uint(tokW[t * 8 + k]))) * (1.0f / 32.0f);
            const int ee = (e < 0 || e > 63) ? 0 : e;
            const unsigned char* yr = Y + ((size_t)toff[ee] * 256 + sl) * DM + 16 * F.lane;
#pragma unroll
            for (int j = 0; j < 2; ++j) fp8x16_fma(a[j], *(const u32x4*)(yr + 1024 * j), wk);
        }
#pragma unroll
        for (int j = 0; j < 2; ++j)
#pragma unroll
            for (int q = 0; q < 4; ++q) { const size_t o = (size_t)t * DM + 16 * F.lane + 1024 * j + 4 * q;
                *(f32x4*)(F.out + o) = *(const f32x4*)(X1 + o) + g5[j][q] * a[j][q]; }
    }
}

__device__ __forceinline__ void stagger(const Frame& F, unsigned ticks_per_step) {
    const unsigned long long t0 = __builtin_amdgcn_s_memrealtime(); const unsigned long long want = (unsigned long long)((blockIdx.x >> 3) & 31u) * ticks_per_step;
    while (__builtin_amdgcn_s_memrealtime() - t0 < want) __builtin_amdgcn_s_sleep(4);
}

constexpr int N_PHASES = 14;
__global__ void __launch_bounds__(NTHREADS, 2) mk_fwd(Args args) {
    extern __shared__ __attribute__((aligned(16))) unsigned char lds[];
    Frame F;
    F.lds = (LAS unsigned char*)lds;
    F.MISC = (volatile LAS unsigned*)(F.lds + MISC_OFF);
    F.tid = threadIdx.x; F.lane = F.tid & 63; F.wave = __builtin_amdgcn_readfirstlane(F.tid >> 6);
    F.G = gridDim.x; { const int bx = blockIdx.x; F.vcu = (F.G % 8 == 0) ? (bx % 8) * (F.G / 8) + bx / 8 : bx; }
    F.ws = args.ws; F.ctl = (unsigned*)(args.ws + WS_CTL); F.out = args.out;
    F.ap = (KArgs)__builtin_amdgcn_kernarg_segment_ptr();
    for (int u = F.tid; u < (LDS_BYTES - LDSCTL_OFF) / 4; u += NTHREADS) ((LAS unsigned*)(F.lds + LDSCTL_OFF))[u] = 0u;
    __syncthreads();
    XcdBarrier bar; bar.bar = F.ctl + CW_BAR; bar.x = 0; bar.st = nullptr;
    if (args.one_launch) bar = xcd_barrier_post(F.ctl + CW_BAR, F.MISC + 8, F.tid == 0);
    const int lo = args.ph_lo, hi = args.ph_hi;
#ifndef DUP_PHASE
#define DUP_PHASE -1
#endif
#define REPS(k) for (int rep_ = 0; rep_ < ((k) == DUP_PHASE ? 2 : 1); ++rep_)
#ifndef PH_MASK
#define PH_MASK 0x3fff
#endif
#define IN(k) (((PH_MASK >> (k)) & 1) && lo <= (k) && (k) < hi)
#define SEAM(k) do { if (IN(k) && IN((k) + 1)) xcd_barrier(bar, F.wave); } while (0)

    if (IN(0)) REPS(0) { RELAUNDER(); if (rep_) xcd_barrier(bar, F.wave); p0_prologue(F); } SEAM(0);
    if (IN(1)) REPS(1) { RELAUNDER(); if (rep_) xcd_barrier(bar, F.wave); norm_mod_rows<false>(F, F.vcu * NWAVES + F.wave, MT, F.G * NWAVES, INP(I_NMIX), 0, (bf16_t*)(F.ws + WS_H), nullptr, true); } SEAM(1);
    if (IN(2)) REPS(2) { RELAUNDER(); if (rep_) xcd_barrier(bar, F.wave); pg8::Gemm g{(const bf16_t*)(F.ws + WS_H), (const bf16_t*)(F.ws + WS_WIN), DM, INW, DM, INW / 256, (size_t)DM * INW * 2}; pg8::StaticOrder S; S.init(MT, INW, F.G, (int)blockIdx.x);
        pg8::EpiProj E{(bf16_t*)(F.ws + WS_P), INW, INP(I_QNA), INP(I_KNA), INP(I_QNB), INP(I_KNB), (const f32x4*)(F.ws + WS_CS), (LAS float*)(F.lds + RING_BYTES)};
        pg8::gemm_phase<pg8::EpiProj, pg8::StaticOrder, true>(F.lds, g, S, E, F.tid); }
    SEAM(3);
    if (IN(4)) REPS(4) { RELAUNDER(); if (rep_) xcd_barrier(bar, F.wave);
        const attn::bf16* P = (const attn::bf16*)(F.ws + WS_P);
#if P0_EXPERTS
#define XSIDE(st) NoSide{}
#else
#define XSIDE(st) XcvtSide{&F, (F.G == 256) ? (st) : (1 << 20)}
#endif
#ifndef NO_GQA
        for (int U = F.vcu; U < 256; U += F.G) { const int he = U >> 5, qb = U & 31; RELAUNDER();
#if GQA_DMA_BODY
            attn::attn_dma_body<4>(P + (size_t)(CTXL + qb * 256) * INW + C_AQ + he * 128, P + C_AK + (he >> 2) * 128, P + C_AV + (he >> 2) * 128,
                                   (float*)(F.ws + WS_OA) + (size_t)(qb * 256) * 1024 + he * 128, MT, F.lds, F.tid, XSIDE(0)); }
#else
            attn::attn_dense_body(P + (size_t)(CTXL + qb * 256) * INW + C_AQ + he * 128, P + C_AK + (he >> 2) * 128, P + C_AV + (he >> 2) * 128,
                                  (float*)(F.ws + WS_OA) + (size_t)(qb * 256) * 1024 + he * 128, MT, (char*)lds, F.tid); }
#endif
#endif
#ifndef NO_DIFF
        for (int U = F.vcu; U < 256; U += F.G) { const int hm = U >> 5, qb = U & 31, h = hm >> 1, m = hm & 1; RELAUNDER();
            attn::attn_dma_body<8>(P + (size_t)(CTXL + qb * 256) * INW + C_BQ + hm * 128, P + C_BK + hm * 128, P + C_BV + h * 256,
                                 (float*)(F.ws + (m ? WS_OB1 : WS_OB0)) + (size_t)(qb * 256) * 1024 + h * 256, MT, F.lds, F.tid, XSIDE(MT / 64)); }
#endif
#if !P0_EXPERTS
        if (F.G != 256) { RELAUNDER(); for (int J = F.vcu * NWAVES + F.wave; J < XJ_TOTAL; J += F.G * NWAVES) { const float* src; int ld; bf16_t* dst; float v[8];
            xjob_decode(F, J, F.lane, src, ld, dst); cvt_load8(v, src, ld); cvt_store8(v, dst); } }
#endif
    } SEAM(4);
    if (IN(5)) REPS(5) { RELAUNDER(); if (rep_) xcd_barrier(bar, F.wave); p5_combine(F); }
    SEAM(6);
    if (IN(7)) REPS(7) { RELAUNDER(); if (rep_) xcd_barrier(bar, F.wave); pg8::Gemm g{(const bf16_t*)(F.ws + WS_A2), (const bf16_t*)(F.ws + WS_WAB), DM, DM, DM, DM / 256, (size_t)DM * DM * 2}; pg8::StaticOrder S; S.init(SEQ, DM, F.G, (int)blockIdx.x);
        pg8::EpiGate2Bf16 E{(bf16_t*)(F.ws + WS_Y), DM, (const bf16_t*)(F.ws + WS_P), INW, CTXL, C_GA, C_GB};
        pg8::gemm_phase<pg8::EpiGate2Bf16, pg8::StaticOrder, false>(F.lds, g, S, E, F.tid); } SEAM(7);
    if (IN(8)) REPS(8) { RELAUNDER(); if (rep_) xcd_barrier(bar, F.wave); pg8::Gemm g{(const bf16_t*)(F.ws + WS_Y), (const bf16_t*)(F.ws + WS_WO), DM, DM, DM, DM / 256, (size_t)DM * DM * 2}; pg8::StaticOrder S; S.init(SEQ, DM, F.G, (int)blockIdx.x);
        pg8::EpiResidF32 E{(float*)(F.ws + WS_X1), INP(I_X), DM, (const float*)(F.ws + WS_MOD) + 2 * DM};
        pg8::gemm_phase<pg8::EpiResidF32, pg8::StaticOrder, false>(F.lds, g, S, E, F.tid); }
    SEAM(9);
    if (IN(10)) REPS(10) { RELAUNDER(); if (rep_) xcd_barrier(bar, F.wave); p10_router(F); } SEAM(10);
    if (IN(11)) REPS(11) { RELAUNDER(); if (rep_) xcd_barrier(bar, F.wave); moe_tables(F);
        const LAS int* tab = (const LAS int*)(F.lds + TAB_OFF);
        pg8::Gemm g{(const bf16_t*)(F.ws + WS_H2HI), (const bf16_t*)(F.ws + WS_WGU), DM, NP_GU, DM, 4, GU_BYTES};
        pg8::MoeOrder S{tab, tab + 65, (const int*)(F.ws + WS_LIST), F.G, F.vcu, 4, __builtin_amdgcn_readfirstlane(tab[65 + 65]) * 4, true};
        pg8::EpiSwiglu E{(bf16_t*)(F.ws + WS_ACT), FE};
        pg8::gemm_phase<pg8::EpiSwiglu, pg8::MoeOrder, true>(F.lds, g, S, E, F.tid); } SEAM(11);
    if (IN(12)) REPS(12) { RELAUNDER(); if (rep_) xcd_barrier(bar, F.wave); moe_tables(F);
        const LAS int* tab = (const LAS int*)(F.lds + TAB_OFF);
        pg8::Gemm g{(const bf16_t*)(F.ws + WS_ACT), (const bf16_t*)(F.ws + WS_WD), FE, NP_D, FE, 8, D_BYTES};
        pg8::MoeOrder S{tab, tab + 65, (const int*)(F.ws + WS_LIST), F.G, F.vcu, 8, __builtin_amdgcn_readfirstlane(tab[65 + 65]) * 8, false};
        pg8::EpiFp8 E{(unsigned char*)(F.ws + WS_YROWS), DM};
        pg8::gemm_phase<pg8::EpiFp8, pg8::MoeOrder, true>(F.lds, g, S, E, F.tid); } SEAM(12);
    if (IN(13)) REPS(13) { RELAUNDER(); if (rep_) xcd_barrier(bar, F.wave); moe_tables(F); p13_final(F); }
#undef IN
#undef SEAM
}

extern "C" void kernel_launch(void* const* d_in, const int* in_sizes, int n_in, void* d_out, int out_size, void* d_ws, size_t ws_size, hipStream_t stream) {
    static int grid = 0;
    if (grid == 0) {
        if (n_in != 29 || in_sizes[0] != SEQ * DM || out_size != SEQ * DM || ws_size < WS_END) {
            fprintf(stderr, "kernel_launch: shape/workspace mismatch: n_in %d in0 %d out %d ws %zu (need %zu)\n", n_in, n_in > 0 ? in_sizes[0] : -1, out_size, ws_size, (size_t)WS_END); grid = -1; return; }
        int dev = 0, cus = 0, per_cu = 0;
        if (hipGetDevice(&dev) != hipSuccess || hipDeviceGetAttribute(&cus, hipDeviceAttributeMultiprocessorCount, dev) != hipSuccess) { grid = -1; return; }
        if (hipFuncSetAttribute((const void*)mk_fwd, hipFuncAttributeMaxDynamicSharedMemorySize, LDS_BYTES) != hipSuccess) { fprintf(stderr, "kernel_launch: hipFuncSetAttribute failed\n"); grid = -1; return; }
        if (hipOccupancyMaxActiveBlocksPerMultiprocessor(&per_cu, (const void*)mk_fwd, NTHREADS, LDS_BYTES) != hipSuccess || per_cu < 1)
            fprintf(stderr, "kernel_launch: occupancy query reports %d\n", per_cu);
        (void)hipGetLastError();
        grid = cus;
    }
    if (grid < 0) return;
    if (hipMemsetAsync((char*)d_ws + WS_CTL, 0, CTL_ZERO_BYTES, stream) != hipSuccess) return;
    Args a{};
    for (int i = 0; i < 29; ++i) a.in[i] = (const float*)d_in[i];
    a.out = (float*)d_out; a.ws = (unsigned char*)d_ws; a.pad = 0;
#if MK_ONE_LAUNCH
    a.ph_lo = 0; a.ph_hi = N_PHASES; a.one_launch = 1;
    hipLaunchKernelGGL(mk_fwd, dim3(grid), dim3(NTHREADS), LDS_BYTES, stream, a);
#else
    for (int p = 0; p < N_PHASES; ++p) { a.ph_lo = p; a.ph_hi = p + 1; a.one_launch = 0;
        for (int rep = 0; rep < (((HOST_DUP_MASK >> p) & 1) ? 2 : 1); ++rep)
        hipLaunchKernelGGL(mk_fwd, dim3(grid), dim3(NTHREADS), LDS_BYTES, stream, a); }
#endif
    const hipError_t le = hipPeekAtLastError();
    if (le != hipSuccess) fprintf(stderr, "kernel_launch: launch failed: %s\n", hipGetErrorName(le));
}
```

```cpp
#include <hip/hip_runtime.h>
#include <hip/hip_bf16.h>
#include <cstdio>
#include <cstdint>

#ifndef STAG_TICKS
#define STAG_TICKS 20
#endif
#ifndef RING_COUNTED
#define RING_COUNTED 0
#endif
#ifndef P0_EXPERTS
#define P0_EXPERTS 0
#endif
#ifndef GQA_DMA_BODY
#define GQA_DMA_BODY 1
#endif
#ifndef EPI_TWICE
#define EPI_TWICE 0
#endif
#ifndef HOST_DUP_MASK
#define HOST_DUP_MASK 0
#endif
#ifndef MK_ONE_LAUNCH
#define MK_ONE_LAUNCH 1
#endif

#define GAS __attribute__((address_space(1)))
#define LAS __attribute__((address_space(3)))
typedef unsigned short bf16_t;
typedef short bf16x8 __attribute__((ext_vector_type(8)));
typedef float f32x4 __attribute__((ext_vector_type(4)));
typedef float f32x2 __attribute__((ext_vector_type(2)));
typedef float f32x16 __attribute__((ext_vector_type(16)));
typedef unsigned u32x4 __attribute__((ext_vector_type(4)));
typedef unsigned u32x2 __attribute__((ext_vector_type(2)));
typedef short s16x4 __attribute__((ext_vector_type(4)));

constexpr int DM = 2048, SEQ = 8192, CTXL = 256, MT = SEQ + CTXL;
constexpr int INW = 8704;
constexpr int C_AQ = 0, C_AK = 1024, C_AV = 1280, C_BQ = 1536, C_BK = 2560, C_BV = 3584, C_GA = 4608, C_GB = 6656;
constexpr int NE = 64, TOPK = 8, FE = 512, NMOD = 6;
constexpr int SH_TILE0 = 320;
constexpr int MOE_ROWS = (SH_TILE0 + 32) * 256;
constexpr float EPS = 1e-6f;
__host__ __device__ constexpr int rope_e(int p) { return (((((p >> 3) * 4 + (p & 3)) >> 5) * 64) + ((((p >> 3) * 4 + (p & 3))) & 31) + 32 * ((p >> 2) & 1)); }
__host__ __device__ constexpr bool is_qk_col(int n) { return n < 1280 || (n >= 1536 && n < 3584); }
constexpr int NWAVES = 8, NTHREADS = 512;

constexpr size_t MiB = 1u << 20;
constexpr size_t WS_CTL = 0, CTL_ZERO_BYTES = 1 * MiB;
constexpr size_t WS_MODP = 1 * MiB;
constexpr size_t WS_MOD = WS_MODP + 512 * 1024;
constexpr size_t WS_TOKE = 2 * MiB, WS_TOKS = WS_TOKE + 256 * 1024, WS_TOKW = WS_TOKS + 256 * 1024;
constexpr size_t WS_LIST = 3 * MiB;
constexpr size_t WS_WRHI = 5 * MiB, WS_WRLO = WS_WRHI + 256 * 1024;
constexpr size_t WS_WIN = 8 * MiB;
constexpr size_t WS_WAB = 42 * MiB, WS_WO = 50 * MiB;
constexpr int NP_GU = 1024 + 16, NP_D = 2048 + 16;
constexpr size_t GU_BYTES = (size_t)(DM / 8) * NP_GU * 16, D_BYTES = (size_t)(FE / 8) * NP_D * 16;
constexpr size_t WS_WGU = 58 * MiB;
constexpr size_t WS_WD = 324 * MiB;
constexpr size_t WS_X1 = 456 * MiB;
constexpr size_t WS_CS = WS_X1;
constexpr size_t WS_ACT = 520 * MiB;
constexpr size_t WS_OVER = 608 * MiB;
constexpr size_t WS_YROWS = WS_OVER;
constexpr size_t WS_H = WS_OVER;
constexpr size_t WS_Y = WS_OVER;
constexpr size_t WS_P = WS_OVER + 34 * MiB;
constexpr size_t WS_H2HI = WS_P, WS_H2LO = WS_P + 32 * MiB;
constexpr size_t WS_OA = WS_OVER + 176 * MiB, WS_OB0 = WS_OA + 32 * MiB, WS_OB1 = WS_OB0 + 32 * MiB;
constexpr size_t WS_Y1 = WS_OA;
constexpr size_t WS_A2 = WS_OVER + 272 * MiB;
constexpr size_t WS_END = WS_OVER + 352 * MiB;
static_assert(WS_P + (size_t)MT * INW * 2 <= WS_OA && WS_A2 + 32 * MiB <= WS_END && WS_H + (size_t)MT * DM * 2 <= WS_P, "ws map");
static_assert(WS_WGU + 65 * GU_BYTES <= WS_WD && WS_WD + 65 * D_BYTES <= WS_X1 && WS_X1 + 64 * MiB <= WS_ACT && WS_ACT + (size_t)MOE_ROWS * FE * 2 <= WS_OVER, "ws map 2");
constexpr int CW_TMO = 0;
constexpr int CW_ADA = 2048;
constexpr int CW_CNT = 1024;
constexpr int CW_BAR = 4096;

constexpr int RING_BYTES = 131072;
constexpr int ATT_BYTES = 3 * 16384 + 3 * 32768 + 2048;
constexpr int LDSCTL_OFF = 150528, MISC_OFF = LDSCTL_OFF + 320, TAB_OFF = LDSCTL_OFF + 1024;
constexpr int LDS_BYTES = 163840;
static_assert(ATT_BYTES <= LDSCTL_OFF && RING_BYTES <= LDSCTL_OFF && TAB_OFF + 1024 <= LDS_BYTES, "LDS map");

#define RLX_AGENT __ATOMIC_RELAXED, __HIP_MEMORY_SCOPE_AGENT
#define LDS_WAIT() asm volatile("s_waitcnt lgkmcnt(0)" ::: "memory")
#define VM_WAIT() asm volatile("s_waitcnt vmcnt(0)" ::: "memory")
__device__ __forceinline__ int lane_id_v() { int l; asm volatile("v_mbcnt_lo_u32_b32 %0, -1, 0\n\tv_mbcnt_hi_u32_b32 %0, -1, %0" : "=v"(l)); return l; }
__device__ __forceinline__ unsigned f2bf(float f) { unsigned u = __builtin_bit_cast(unsigned, f); return (u + 0x7fffu + ((u >> 16) & 1u)) >> 16; }
__device__ __forceinline__ unsigned pk2(float lo, float hi) { return f2bf(lo) | (f2bf(hi) << 16); }
__device__ __forceinline__ float bf2f(unsigned short b) { return __uint_as_float((unsigned)b << 16); }
__device__ __forceinline__ float bflo(unsigned w) { return __uint_as_float(w << 16); }
__device__ __forceinline__ float bfhi(unsigned w) { return __uint_as_float(w & 0xffff0000u); }
__device__ __forceinline__ unsigned cvt_pk_bf16(float lo, float hi) { unsigned r; asm volatile("v_cvt_pk_bf16_f32 %0, %1, %2" : "=v"(r) : "v"(lo), "v"(hi)); return r; }
__device__ __forceinline__ float sigmoidf_(float x) { return __builtin_amdgcn_rcpf(1.0f + __expf(-x)); }
__device__ __forceinline__ float wave_sum(float v) {
#pragma unroll
    for (int o = 1; o < 64; o <<= 1) v += __shfl_xor(v, o);
    return v;
}

#define XB_TMO      128
#define XB_XCNT(j)  (256  + 64 * (j))
#define XB_XSUB(j)  (1280 + 64 * (j))
#define XB_XGEN(j)  (2304 + 64 * (j))
#define XB_TOP      3328
#define XB_TOPGEN   3392
#define XCD_BAR_WORDS 3456
#define XB_SPIN_CAP (1u << 18)
__device__ __forceinline__ unsigned xb_ld(unsigned* p)              { return __hip_atomic_load(p, __ATOMIC_RELAXED, __HIP_MEMORY_SCOPE_AGENT); }
__device__ __forceinline__ unsigned xb_add(unsigned* p, unsigned v) { return __hip_atomic_fetch_add(p, v, __ATOMIC_RELAXED, __HIP_MEMORY_SCOPE_AGENT); }
__device__ __forceinline__ unsigned xb_xcc_id() { return (unsigned)__builtin_amdgcn_s_getreg((3 << 11) | 20) & 0xFu; }
#define XB_SPIN(cond, bar) do { unsigned _sp = 0; while (cond) { __builtin_amdgcn_s_sleep(1); \
    if ((++_sp & 255u) == 0u) { if (xb_ld(&(bar)[XB_TMO])) break; if (_sp > XB_SPIN_CAP) { atomicAdd(&(bar)[XB_TMO], 1u); break; } } } } while (0)
struct XcdBarrier { unsigned* bar; unsigned x; volatile LAS unsigned* st; };
__device__ __forceinline__ XcdBarrier xcd_barrier_post(unsigned* bar, volatile LAS unsigned* st, bool leader) {
    XcdBarrier b; b.bar = bar; b.x = xb_xcc_id(); b.st = st;
    if (leader) (void)xb_add(&bar[XB_XCNT(b.x)], 1u);
    return b;
}
__device__ __forceinline__ void xcd_barrier_complete(unsigned* bar, unsigned x, unsigned& nloc, unsigned& nx) {
    const unsigned G = gridDim.x * gridDim.y * gridDim.z;
    unsigned sum, cnt, mine, sp = 0u;
    for (;;) {
        sum = 0u; cnt = 0u; mine = 0u;
#pragma unroll
        for (unsigned j = 0; j < 16; ++j) { const unsigned c = xb_ld(&bar[XB_XCNT(j)]); sum += c; cnt += (c > 0u) ? 1u : 0u; mine = (j == x) ? c : mine; }
        if (sum == G) break;
        __builtin_amdgcn_s_sleep(1);
        if ((++sp & 255u) == 0u) { if (xb_ld(&bar[XB_TMO])) break; if (sp > XB_SPIN_CAP) { atomicAdd(&bar[XB_TMO], 1u); break; } }
    }
    nloc = mine > 0u ? mine : 1u; nx = cnt > 0u ? cnt : 1u;
}
__device__ __forceinline__ void xcd_barrier(const XcdBarrier& b, int wave) {
    asm volatile("s_waitcnt vmcnt(0)" ::: "memory");
    __syncthreads();
    if (wave == 0 && lane_id_v() == 0) {
        unsigned* bar = b.bar;
        __builtin_amdgcn_s_waitcnt(0);
        unsigned nloc = b.st[0], nx = b.st[1];
        if (nloc == 0u) { xcd_barrier_complete(bar, b.x, nloc, nx); b.st[0] = nloc; b.st[1] = nx; }
        const unsigned old = xb_add(&bar[XB_XSUB(b.x)], 1u);
        const unsigned gen = old / nloc;
        if (old + 1u == (gen + 1u) * nloc) {
            __builtin_amdgcn_fence(__ATOMIC_RELEASE, "agent");
            asm volatile("s_waitcnt vmcnt(0)" ::: "memory");
            const unsigned og = xb_add(&bar[XB_TOP], 1u);
            const unsigned tg = og / nx;
            if (og + 1u == (tg + 1u) * nx) xb_add(&bar[XB_TOPGEN], 1u);
            else XB_SPIN(xb_ld(&bar[XB_TOPGEN]) == tg, bar);
            __builtin_amdgcn_fence(__ATOMIC_ACQUIRE, "agent");
            xb_add(&bar[XB_XGEN(b.x)], 1u);
            asm volatile("s_waitcnt vmcnt(0)" ::: "memory");
        } else {
            XB_SPIN(xb_ld(&bar[XB_XGEN(b.x)]) == gen, bar);
            __builtin_amdgcn_fence(__ATOMIC_ACQUIRE, "agent");
            asm volatile("s_waitcnt vmcnt(0)" ::: "memory");
        }
    }
    __syncthreads();
}

namespace pg8 {
constexpr int BM = 256, BK = 64, HALF = 128, HTB = HALF * BK * 2, STAGE_BYTES = 8 * HTB;
__host__ __device__ __forceinline__ int lds_byte(int r, int c) { const int st = (r >> 4) * 2 + (c >> 5), rr = r & 15, cc = c & 31, ob = rr * 64 + cc * 2; return st * 1024 + (ob ^ (((ob >> 9) & 1) << 5)); }
__host__ __device__ __forceinline__ void stage_rc(int b, int& R, int& C) { const int st = b / 1024, sb = b % 1024, swz = sb ^ (((sb >> 9) & 1) << 5); R = (st >> 1) * 16 + swz / 64; C = (st & 1) * 32 + (swz % 64) / 2; }
__host__ __device__ __forceinline__ int perm32(int rho) { const int n = rho >> 4, i = rho & 15; return 8 * (i >> 2) + 4 * n + (i & 3); }

struct Unit { int pm, pn, pb, e, mt, cnt; };
struct Gemm { const bf16_t* A; const bf16_t* Bt; int lda, ldb, K; int nNb; size_t matBytes; };

struct StaticOrder {
    int nM, nN, nwg, G, c;
    __device__ void init(int M, int N, int G_, int c_) { nM = M / BM; nN = N / BM; nwg = nM * nN; G = G_; c = c_; }
    __device__ __forceinline__ bool next(int i, Unit& u) const {
        const long L = (long)i * G + c; if (L >= nwg) return false;
        int wgid = (int)L; { const int q = nwg / 8, r = nwg % 8, xcd = wgid % 8, off = wgid / 8; wgid = (xcd < r ? xcd * (q + 1) : r * (q + 1) + (xcd - r) * q) + off; }
        const int nig = 8 * nN, gid = wgid / nig, fm = gid * 8, gsz = (nM - fm) < 8 ? (nM - fm) : 8;
        u.pm = fm + ((wgid % nig) % gsz); u.pn = (wgid % nig) / gsz; u.pb = u.pn; u.e = 0; u.mt = 0; u.cnt = 0; return true;
    }
    __device__ __forceinline__ int arow(const Unit& u, int r) const { return u.pm * BM + r; }
};
struct MoeOrder {
    const LAS int* cnt; const LAS int* toff; const int* list; int G, c, nN, total; bool gather;
    __device__ __forceinline__ bool next(int i, Unit& u) const {
        const int L = i * G + c; if (L >= total) return false;
        const int rt = L / nN, nt = L % nN;
        int e = 0;
#pragma unroll
        for (int j = 64; j >= 1; j >>= 1) { const int t = e + j; if (t <= 64 && toff[t] <= rt) e = t; }
        e = __builtin_amdgcn_readfirstlane(e);
        const int mt = rt - __builtin_amdgcn_readfirstlane(toff[e]);
        u.e = e; u.mt = mt; u.cnt = __builtin_amdgcn_readfirstlane(cnt[e]);
        u.pm = (e < 64) ? rt : SH_TILE0 + mt; u.pn = nt; u.pb = e * nN + nt; return true;
    }
    __device__ __forceinline__ int arow(const Unit& u, int r) const {
        if (!gather) return u.pm * BM + r;
        const int s = u.mt * BM + r;
        if (u.e == 64) return s;
        return s < u.cnt ? list[u.e * SEQ + s] : 0;
    }
};

#define EPI_LOOP_BEGIN int row0_ = u.pm * BM + wr * 64 + fr; int colL_ = wc * 32 + 8 * fq; asm volatile("" : "+v"(row0_), "+v"(colL_));     \
    _Pragma("unroll") for (int ai = 0; ai < 2; ++ai) _Pragma("unroll") for (int m = 0; m < 4; ++m) { const int row = row0_ + ai * HALF + m * 16;
#define EPI_LOOP_END }

struct EpiBf16 {
    static constexpr bool MIDHOOK = false;
    bf16_t* O; int ldc;
    __device__ __forceinline__ void operator()(const f32x4 (&acc)[2][2][4][2], const Unit& u, int wr, int wc, int fr, int fq) const {
        EPI_LOOP_BEGIN
            bf16_t* rowp = O + (size_t)row * ldc + u.pn * BM + colL_;
#pragma unroll
            for (int bj = 0; bj < 2; ++bj) { const f32x4 v0 = acc[ai][bj][m][0], v1 = acc[ai][bj][m][1];
                u32x4 w; w.x = cvt_pk_bf16(v0[0], v0[1]); w.y = cvt_pk_bf16(v0[2], v0[3]); w.z = cvt_pk_bf16(v1[0], v1[1]); w.w = cvt_pk_bf16(v1[2], v1[3]);
                *(u32x4*)(rowp + bj * HALF) = w; }
        EPI_LOOP_END
    }
};
struct EpiFp8 {
    static constexpr bool MIDHOOK = false;
    unsigned char* O; int ldc;
    __device__ __forceinline__ void operator()(const f32x4 (&acc)[2][2][4][2], const Unit& u, int wr, int wc, int fr, int fq) const {
        EPI_LOOP_BEGIN
            unsigned char* rowp = O + (size_t)row * ldc + u.pn * BM + colL_;
#pragma unroll
            for (int bj = 0; bj < 2; ++bj) { f32x4 v0 = acc[ai][bj][m][0] * 32.0f, v1 = acc[ai][bj][m][1] * 32.0f;
#pragma unroll
                for (int q = 0; q < 4; ++q) { v0[q] = __builtin_amdgcn_fmed3f(v0[q], -440.0f, 440.0f); v1[q] = __builtin_amdgcn_fmed3f(v1[q], -440.0f, 440.0f); }
                int w0 = __builtin_amdgcn_cvt_pk_fp8_f32(v0[0], v0[1], 0, false); w0 = __builtin_amdgcn_cvt_pk_fp8_f32(v0[2], v0[3], w0, true);
                int w1 = __builtin_amdgcn_cvt_pk_fp8_f32(v1[0], v1[1], 0, false); w1 = __builtin_amdgcn_cvt_pk_fp8_f32(v1[2], v1[3], w1, true);
                u32x2 w; w.x = (unsigned)w0; w.y = (unsigned)w1; *(u32x2*)(rowp + bj * HALF) = w; }
        EPI_LOOP_END
    }
};
struct EpiProj {
    static constexpr bool MIDHOOK = false;
    bf16_t* O; int ldc; const float* gqa; const float* gka; const float* gqb; const float* gkb; const f32x4* cs; LAS float* ps;
    __device__ __forceinline__ void operator()(f32x4 (&acc)[2][2][4][2], const Unit& u, int wr, int wc, int fr, int fq) const {
        const int pn = u.pn;
        const bool isq = pn < 4 || (pn >= 6 && pn < 10), isk = pn == 4 || (pn >= 10 && pn < 14);
        if (isq || isk) {
            const bool lat = u.pm > 0;
            const float qs = isq ? 0.088388347648318440f * 1.4426950408889634f : 1.0f;
#pragma unroll
            for (int ai = 0; ai < 2; ++ai)
#pragma unroll
                for (int m = 0; m < 4; ++m)
#pragma unroll
                    for (int bj = 0; bj < 2; ++bj) { const f32x4 a = acc[ai][bj][m][0], b = acc[ai][bj][m][1];
                        float ss = (a[0] * a[0] + a[1] * a[1]) + (a[2] * a[2] + a[3] * a[3]) + (b[0] * b[0] + b[1] * b[1]) + (b[2] * b[2] + b[3] * b[3]);
                        ss += __shfl_xor(ss, 16); ss += __shfl_xor(ss, 32);
                        if (fq == 0) ps[((ai * HALF + wr * 64 + m * 16 + fr) * 2 + bj) * 4 + wc] = ss; }
            asm volatile("s_waitcnt lgkmcnt(0)" ::: "memory"); __builtin_amdgcn_s_barrier(); asm volatile("" ::: "memory");
            const int pi0 = (4 * wc + fq) * 4, e0 = ((pi0 >> 5) * 64) + (pi0 & 31);
            f32x4 g1, g2;
            { const f32x4 a1 = *(const f32x4*)(gqa + e0), a2 = *(const f32x4*)(gqa + e0 + 32), b1 = *(const f32x4*)(gka + e0), b2 = *(const f32x4*)(gka + e0 + 32);
              const f32x4 c1 = *(const f32x4*)(gqb + e0), c2 = *(const f32x4*)(gqb + e0 + 32), d1 = *(const f32x4*)(gkb + e0), d2 = *(const f32x4*)(gkb + e0 + 32);
              const float wa = pn < 4 ? 1.f : 0.f, wb = pn == 4 ? 1.f : 0.f, wc_ = (pn >= 6 && pn < 10) ? 1.f : 0.f, wd = pn >= 10 ? 1.f : 0.f;
              g1 = a1 * wa + b1 * wb + c1 * wc_ + d1 * wd; g2 = a2 * wa + b2 * wb + c2 * wc_ + d2 * wd; }
            int row0_ = u.pm * BM + wr * 64 + fr; asm volatile("" : "+v"(row0_));
#pragma unroll
            for (int ai = 0; ai < 2; ++ai)
#pragma unroll
                for (int m = 0; m < 4; ++m) { const int rl = ai * HALF + wr * 64 + m * 16 + fr, row = row0_ + ai * HALF + m * 16;
                    f32x4 c4 = {1.f, 1.f, 1.f, 1.f}, s4 = {0.f, 0.f, 0.f, 0.f};
                    if (lat) { const f32x4* cp = cs + ((size_t)(row - CTXL) * 64 + pi0) / 2; const f32x4 x0 = cp[0], x1 = cp[1];
                        c4 = (f32x4){x0[0], x0[2], x1[0], x1[2]}; s4 = (f32x4){x0[1], x0[3], x1[1], x1[3]}; }
#pragma unroll
                    for (int bj = 0; bj < 2; ++bj) { const f32x4 p4 = *(const LAS f32x4*)(ps + (rl * 2 + bj) * 4);
                        const float rstd = 1.0f / sqrtf(((p4[0] + p4[1]) + (p4[2] + p4[3])) * (1.0f / 128.0f) + EPS);
                        const f32x4 u1 = acc[ai][bj][m][0] * rstd * g1, u2 = acc[ai][bj][m][1] * rstd * g2;
                        acc[ai][bj][m][0] = (u1 * c4 - u2 * s4) * qs; acc[ai][bj][m][1] = (u1 * s4 + u2 * c4) * qs; }
                    asm volatile("" : "+v"(acc[ai][0][m][0]), "+v"(acc[ai][0][m][1]), "+v"(acc[ai][1][m][0]), "+v"(acc[ai][1][m][1]) :: "memory"); }
        }
        EPI_LOOP_BEGIN
            bf16_t* rowp = O + (size_t)row * ldc + u.pn * BM + colL_;
#pragma unroll
            for (int bj = 0; bj < 2; ++bj) { const f32x4 v0 = acc[ai][bj][m][0], v1 = acc[ai][bj][m][1];
                u32x4 w; w.x = cvt_pk_bf16(v0[0], v0[1]); w.y = cvt_pk_bf16(v0[2], v0[3]); w.z = cvt_pk_bf16(v1[0], v1[1]); w.w = cvt_pk_bf16(v1[2], v1[3]);
                *(u32x4*)(rowp + bj * HALF) = w; }
        EPI_LOOP_END
    }
};
struct EpiGate2Bf16 {
    static constexpr bool MIDHOOK = true;
    bf16_t* O; int ldc; const bf16_t* Gt; int ldg; int grow0, gcolA, gcolB;
    __device__ __forceinline__ void mid(f32x4 (&acc)[2][2][4][2], const Unit& u, int wr, int wc, int fr, int fq) const {
        EPI_LOOP_BEGIN
            const bf16_t* gp = Gt + (size_t)(row + grow0) * ldg + u.pn * BM + colL_;
#pragma unroll
            for (int bj = 0; bj < 2; ++bj) { const u32x4 ga = *(const u32x4*)(gp + gcolA + bj * HALF), gb = *(const u32x4*)(gp + gcolB + bj * HALF);
#define RAT(wa_, wb_, f_) ((1.0f + __expf(-f_(wb_))) * __builtin_amdgcn_rcpf(1.0f + __expf(-f_(wa_))))
                f32x4 r0, r1;
                r0[0] = RAT(ga.x, gb.x, bflo); r0[1] = RAT(ga.x, gb.x, bfhi); r0[2] = RAT(ga.y, gb.y, bflo); r0[3] = RAT(ga.y, gb.y, bfhi);
                r1[0] = RAT(ga.z, gb.z, bflo); r1[1] = RAT(ga.z, gb.z, bfhi); r1[2] = RAT(ga.w, gb.w, bflo); r1[3] = RAT(ga.w, gb.w, bfhi);
#undef RAT
                acc[ai][bj][m][0] = acc[ai][bj][m][0] * r0; acc[ai][bj][m][1] = acc[ai][bj][m][1] * r1; }
            asm volatile("" : "+v"(acc[ai][0][m][0]), "+v"(acc[ai][0][m][1]), "+v"(acc[ai][1][m][0]), "+v"(acc[ai][1][m][1]) :: "memory");
        EPI_LOOP_END
    }
    __device__ __forceinline__ void operator()(const f32x4 (&acc)[2][2][4][2], const Unit& u, int wr, int wc, int fr, int fq) const {
        EPI_LOOP_BEGIN
            const size_t co = (size_t)row * ldc + u.pn * BM + colL_;
            const bf16_t* gp = Gt + (size_t)(row + grow0) * ldg + gcolB + u.pn * BM + colL_;
#pragma unroll
            for (int bj = 0; bj < 2; ++bj) { const u32x4 g = *(const u32x4*)(gp + bj * HALF); const f32x4 v0 = acc[ai][bj][m][0], v1 = acc[ai][bj][m][1];
                f32x4 o0, o1;
                o0[0] = v0[0] * sigmoidf_(bflo(g.x)); o0[1] = v0[1] * sigmoidf_(bfhi(g.x)); o0[2] = v0[2] * sigmoidf_(bflo(g.y)); o0[3] = v0[3] * sigmoidf_(bfhi(g.y));
                o1[0] = v1[0] * sigmoidf_(bflo(g.z)); o1[1] = v1[1] * sigmoidf_(bfhi(g.z)); o1[2] = v1[2] * sigmoidf_(bflo(g.w)); o1[3] = v1[3] * sigmoidf_(bfhi(g.w));
                u32x4 w; w.x = cvt_pk_bf16(o0[0], o0[1]); w.y = cvt_pk_bf16(o0[2], o0[3]); w.z = cvt_pk_bf16(o1[0], o1[1]); w.w = cvt_pk_bf16(o1[2], o1[3]);
                *(u32x4*)(O + co + bj * HALF) = w; }
        EPI_LOOP_END
    }
};
struct EpiResidF32 {
    static constexpr bool MIDHOOK = false;
    float* O; const float* X; int ldc; const float* gate;
    __device__ __forceinline__ void operator()(const f32x4 (&acc)[2][2][4][2], const Unit& u, int wr, int wc, int fr, int fq) const {
        const int colL0 = u.pn * BM + wc * 32 + 8 * fq;
        f32x4 gv[2][2];
#pragma unroll
        for (int bj = 0; bj < 2; ++bj)
#pragma unroll
            for (int n = 0; n < 2; ++n) gv[bj][n] = *(const f32x4*)(gate + colL0 + bj * HALF + 4 * n);
        EPI_LOOP_BEGIN
            const size_t co = (size_t)row * ldc + u.pn * BM + colL_;
#pragma unroll
            for (int bj = 0; bj < 2; ++bj)
#pragma unroll
                for (int n = 0; n < 2; ++n) { const f32x4 x = *(const f32x4*)(X + co + bj * HALF + 4 * n);
                    *(f32x4*)(O + co + bj * HALF + 4 * n) = x + gv[bj][n] * acc[ai][bj][m][n]; }
        EPI_LOOP_END
    }
};
struct EpiSwiglu {
    static constexpr bool MIDHOOK = false;
    bf16_t* O; int ldc;
    __device__ __forceinline__ void operator()(const f32x4 (&acc)[2][2][4][2], const Unit& u, int wr, int wc, int fr, int fq) const {
        EPI_LOOP_BEGIN
            bf16_t* rowp = O + (size_t)row * ldc + u.pn * HALF + colL_;
            f32x4 o[2];
#pragma unroll
            for (int n = 0; n < 2; ++n) { const f32x4 g = acc[ai][0][m][n], up = acc[ai][1][m][n];
#pragma unroll
                for (int j = 0; j < 4; ++j) o[n][j] = g[j] * sigmoidf_(g[j]) * up[j]; }
            u32x4 w; w.x = cvt_pk_bf16(o[0][0], o[0][1]); w.y = cvt_pk_bf16(o[0][2], o[0][3]); w.z = cvt_pk_bf16(o[1][0], o[1][1]); w.w = cvt_pk_bf16(o[1][2], o[1][3]);
            *(u32x4*)rowp = w;
        EPI_LOOP_END
    }
};

template <class Epi, class Sched, bool ALIGN_EPI>
__device__ __forceinline__ void gemm_phase(LAS unsigned char* lds, const Gemm g, const Sched& S, const Epi& E, int tid) {
    asm volatile("" : "+v"(tid));
    const int wid = __builtin_amdgcn_readfirstlane(tid >> 6), lane = tid & 63, wr = wid >> 2, wc = wid & 3, fr = lane & 15, fq = lane >> 4;
    const int K = g.K, nt = K / BK, lda = g.lda, ldb = g.ldb;
    int Rr[2], Cc[2]; unsigned voffB[2];
#pragma unroll
    for (int i = 0; i < 2; ++i) { int R, C; stage_rc(tid * 16 + i * 8192, R, C); Rr[i] = R; Cc[i] = C; const int Rb = (R & ~31) + perm32(R & 31);
        voffB[i] = (unsigned)((C >> 3) * ldb + Rb) * 16u; }
    const size_t kstep = (size_t)(BK * 2);
    const size_t kstepB = (size_t)8 * ldb * 16;
    const size_t hstepB = (size_t)HALF * 16;
#define PG8_BBASE(pb_) ((const char*)g.Bt + (size_t)((pb_) / g.nNb) * g.matBytes + (size_t)((pb_) % g.nNb) * (BM * 16))
    const unsigned ldsw = (unsigned)wid * 1024u;
    const int aoff = lds_byte(wr * 64 + fr, fq * 8), boff = lds_byte(wc * 32 + fr, fq * 8);
#define PG8_SA(b, h) (((b) * 2 + (h)) * HTB)
#define PG8_SB(b, h) ((4 + (b) * 2 + (h)) * HTB)
#define PG8_STAGE2(bufoff, gbase, v0, v1) do { \
        __builtin_amdgcn_global_load_lds((const unsigned*)((const char*)(gbase) + (v0)), (LAS unsigned*)(lds + (bufoff) + ldsw), 16, 0, 0); \
        __builtin_amdgcn_global_load_lds((const unsigned*)((const char*)(gbase) + (v1)), (LAS unsigned*)(lds + (bufoff) + ldsw + 8192), 16, 0, 0); } while (0)
#define PG8_STAGEB(bufoff, gbase) PG8_STAGE2(bufoff, gbase, voffB[0], voffB[1])
#define PG8_LDA(dst, b, h) do { _Pragma("unroll") for (int m = 0; m < 4; ++m) _Pragma("unroll") for (int k = 0; k < 2; ++k) dst[m][k] = *(const LAS bf16x8*)(lds + PG8_SA(b, h) + aoff + m * 2048 + k * 1024); } while (0)
#define PG8_LDB(dst, b, h) do { _Pragma("unroll") for (int n = 0; n < 2; ++n) _Pragma("unroll") for (int k = 0; k < 2; ++k) dst[n][k] = *(const LAS bf16x8*)(lds + PG8_SB(b, h) + boff + n * 2048 + k * 1024); } while (0)
#define PG8_MMA(ai, bj, At, Bt) do { __builtin_amdgcn_s_setprio(1); _Pragma("unroll") for (int m = 0; m < 4; ++m) _Pragma("unroll") for (int n = 0; n < 2; ++n) _Pragma("unroll") for (int k = 0; k < 2; ++k) \
        acc[ai][bj][m][n] = __builtin_amdgcn_mfma_f32_16x16x32_bf16(Bt[n][k], At[m][k], acc[ai][bj][m][n], 0, 0, 0); __builtin_amdgcn_s_setprio(0); } while (0)
#define PG8_WAIT_V(n) asm volatile("s_waitcnt vmcnt(" #n ")" ::: "memory")
#define PG8_WAIT_L(n) asm volatile("s_waitcnt lgkmcnt(" #n ")" ::: "memory")
#define PG8_BAR __builtin_amdgcn_s_barrier()
#define PG8_SCHED __builtin_amdgcn_sched_barrier(0)
#define PG8_SETAO(dst, uu) do { _Pragma("unroll") for (int h_ = 0; h_ < 2; ++h_) _Pragma("unroll") for (int i_ = 0; i_ < 2; ++i_) \
        dst[h_][i_] = (unsigned)(S.arow(uu, h_ * HALF + Rr[i_]) * lda + Cc[i_]) * 2u; } while (0)
    Unit cur, nxt; int ui = 0;
    if (!S.next(0, cur)) return;
    f32x4 acc[2][2][4][2];
#pragma unroll
    for (int a = 0; a < 2; ++a)
#pragma unroll
        for (int b = 0; b < 2; ++b)
#pragma unroll
            for (int m = 0; m < 4; ++m)
#pragma unroll
                for (int n = 0; n < 2; ++n) acc[a][b][m][n] = (f32x4){0.f, 0.f, 0.f, 0.f};
    bf16x8 At[4][2], B0[2][2], B1[2][2];
    unsigned aoC[2][2], aoN[2][2];
    PG8_SETAO(aoC, cur);
    const char* gA = (const char*)g.A;
    const char* cB = PG8_BBASE(cur.pb);
    PG8_STAGEB(PG8_SB(0, 0), cB); PG8_STAGEB(PG8_SB(0, 1), cB + hstepB); PG8_STAGE2(PG8_SA(0, 0), gA, aoC[0][0], aoC[0][1]); PG8_STAGE2(PG8_SA(0, 1), gA, aoC[1][0], aoC[1][1]);
    if (wr == 1) PG8_BAR;
    PG8_WAIT_V(2); PG8_BAR;
    PG8_STAGEB(PG8_SB(1, 0), cB + kstepB); PG8_STAGE2(PG8_SA(1, 0), gA + kstep, aoC[0][0], aoC[0][1]); PG8_STAGEB(PG8_SB(1, 1), cB + hstepB + kstepB);
    PG8_WAIT_V(6); PG8_BAR;
    for (;;) {
        const bool has_next = S.next(ui + 1, nxt);
        if (has_next) { PG8_SETAO(aoN, nxt); }
        else {
#pragma unroll
            for (int h_ = 0; h_ < 2; ++h_)
#pragma unroll
                for (int i_ = 0; i_ < 2; ++i_) aoN[h_][i_] = aoC[h_][i_];
        }
        const char* nB = has_next ? PG8_BBASE(nxt.pb) : cB;
        for (int t = 0; t < nt; t += 2) {
            const bool last = (t == nt - 2);
            if constexpr (Epi::MIDHOOK) { if (t == (nt >> 1)) E.mid(acc, cur, wr, wc, fr, fq); }
            const char* a1 = gA + (size_t)(t + 1) * kstep;
            const char* a2 = last ? gA : gA + (size_t)(t + 2) * kstep; const char* b2 = last ? nB : cB + (size_t)(t + 2) * kstepB;
            const char* a3 = a2 + kstep; const char* b3 = b2 + kstepB;
            const unsigned x00 = last ? aoN[0][0] : aoC[0][0], x01 = last ? aoN[0][1] : aoC[0][1], x10 = last ? aoN[1][0] : aoC[1][0], x11 = last ? aoN[1][1] : aoC[1][1];
            PG8_LDB(B0, 0, 0); PG8_LDB(B1, 0, 1); PG8_SCHED; PG8_LDA(At, 0, 0); PG8_STAGE2(PG8_SA(1, 1), a1, aoC[1][0], aoC[1][1]);
            PG8_WAIT_V(8); PG8_WAIT_L(0); PG8_BAR; PG8_MMA(0, 0, At, B0); PG8_MMA(0, 1, At, B1); PG8_BAR; PG8_SCHED;
            PG8_LDA(At, 0, 1); PG8_STAGEB(PG8_SB(0, 0), b2); PG8_STAGEB(PG8_SB(0, 1), b2 + hstepB); PG8_STAGE2(PG8_SA(0, 0), a2, x00, x01);
            PG8_WAIT_V(8); PG8_WAIT_L(0); PG8_BAR; PG8_MMA(1, 0, At, B0); PG8_MMA(1, 1, At, B1); PG8_BAR; PG8_SCHED;
            PG8_LDB(B0, 1, 0); PG8_LDB(B1, 1, 1); PG8_SCHED; PG8_LDA(At, 1, 0); PG8_STAGE2(PG8_SA(0, 1), a2, x10, x11);
            PG8_WAIT_V(8); PG8_WAIT_L(0); PG8_BAR; PG8_MMA(0, 0, At, B0); PG8_MMA(0, 1, At, B1); PG8_BAR; PG8_SCHED;
            PG8_LDA(At, 1, 1); PG8_STAGEB(PG8_SB(1, 0), b3); PG8_STAGEB(PG8_SB(1, 1), b3 + hstepB); PG8_STAGE2(PG8_SA(1, 0), a3, x00, x01);
            PG8_WAIT_V(8); PG8_WAIT_L(0); PG8_BAR; PG8_MMA(1, 0, At, B0); PG8_MMA(1, 1, At, B1); PG8_BAR; PG8_SCHED;
        }
        if constexpr (ALIGN_EPI) { if (wr == 0) PG8_BAR; }
        E(acc, cur, wr, wc, fr, fq);
#if EPI_TWICE
        asm volatile("" ::: "memory"); E(acc, cur, wr, wc, fr, fq);
#endif
        if (!has_next) break;
#pragma unroll
        for (int a = 0; a < 2; ++a)
#pragma unroll
            for (int b = 0; b < 2; ++b)
#pragma unroll
                for (int m = 0; m < 4; ++m)
#pragma unroll
                    for (int n = 0; n < 2; ++n) acc[a][b][m][n] = (f32x4){0.f, 0.f, 0.f, 0.f};
        cur = nxt; cB = nB; ++ui;
#pragma unroll
        for (int h_ = 0; h_ < 2; ++h_)
#pragma unroll
            for (int i_ = 0; i_ < 2; ++i_) aoC[h_][i_] = aoN[h_][i_];
        if constexpr (ALIGN_EPI) { if (wr == 1) PG8_BAR; }
    }
    PG8_WAIT_V(0);
    if constexpr (!ALIGN_EPI) { if (wr == 0) PG8_BAR; }
    PG8_BAR;
#undef PG8_SA
#undef PG8_SB
#undef PG8_STAGE2
#undef PG8_STAGEB
#undef PG8_LDA
#undef PG8_LDB
#undef PG8_MMA
#undef PG8_WAIT_V
#undef PG8_WAIT_L
#undef PG8_BAR
#undef PG8_SCHED
#undef PG8_SETAO
#undef PG8_BBASE
}
}

__device__ __forceinline__ void cvt_load8(float (&v)[8], const float* src, int ld);
namespace attn {
using bf16 = __hip_bfloat16;
constexpr int D = 128, NW = 8, QBLK = 32, KVBLK = 64;
constexpr float SCALE = 0.088388347648318440f;
constexpr float THR = 8.f;
constexpr int LDQ = INW, LDK = INW, LDO = 1024;
constexpr size_t SHM_V = KVBLK * D * 2, SHM_K = KVBLK * D * 2, SHM_ATTN = 2 * SHM_V + 2 * SHM_K + NW * 64 * 4;
#define KSWZ(row, colB) ((row) * 256 + ((colB) ^ (((row) & 7) << 4)))
#define SBAR() __builtin_amdgcn_sched_barrier(0)
__device__ __forceinline__ int crow(int r, int hi) { return (r & 3) + 8 * (r >> 2) + 4 * hi; }
__device__ __forceinline__ unsigned cvtpk(float lo, float hi) { unsigned r; asm volatile("v_cvt_pk_bf16_f32 %0, %1, %2" : "=v"(r) : "v"(lo), "v"(hi)); return r; }
__device__ __forceinline__ bf16x8 ld8(const bf16* p) { return *reinterpret_cast<const bf16x8*>(p); }

__device__ __forceinline__ void partialSM(f32x16& p0, f32x16& p1, float& m_reg, float& mn, float& alpha) {
  constexpr float C = SCALE * 1.4426950408889634f;
  float pmax = p0[0];
#pragma unroll
  for (int r = 1; r < 16; ++r) pmax = fmaxf(pmax, p0[r]);
#pragma unroll
  for (int r = 0; r < 16; ++r) pmax = fmaxf(pmax, p1[r]);
  { auto rr = __builtin_amdgcn_permlane32_swap(__float_as_uint(pmax), __float_as_uint(pmax), false, false);
    pmax = fmaxf(__uint_as_float(rr[0]), __uint_as_float(rr[1])); }
  if (__builtin_expect(__all(pmax - m_reg <= THR / SCALE), 1)) { mn = m_reg; alpha = 1.f; }
  else { mn = fmaxf(m_reg, pmax); alpha = __builtin_amdgcn_exp2f((m_reg - mn) * C); m_reg = mn; }
  float mnC = -mn * C;
#pragma unroll
  for (int r = 0; r < 16; ++r) p0[r] = fmaf(p0[r], C, mnC);
#pragma unroll
  for (int r = 0; r < 16; ++r) p1[r] = fmaf(p1[r], C, mnC);
#pragma unroll
  for (int r = 0; r < 16; ++r) p0[r] = __builtin_amdgcn_exp2f(p0[r]);
}
__device__ __forceinline__ void finishSM(f32x16& p0, f32x16& p1, float alpha, float& l_reg, bf16x8& pa0, bf16x8& pa1, bf16x8& pa2, bf16x8& pa3) {
#pragma unroll
  for (int r = 0; r < 16; ++r) p1[r] = __builtin_amdgcn_exp2f(p1[r]);
  float ps = 0;
#pragma unroll
  for (int r = 0; r < 16; ++r) ps += p0[r];
#pragma unroll
  for (int r = 0; r < 16; ++r) ps += p1[r];
  { auto rr = __builtin_amdgcn_permlane32_swap(__float_as_uint(ps), __float_as_uint(ps), false, false);
    ps = __uint_as_float(rr[0]) + __uint_as_float(rr[1]); }
  l_reg = l_reg * alpha + ps;
#define PK4(P, BASE, OUT) do { unsigned a0 = cvtpk(P[BASE + 0], P[BASE + 1]), a1 = cvtpk(P[BASE + 2], P[BASE + 3]);   \
    unsigned b0 = cvtpk(P[BASE + 4], P[BASE + 5]), b1 = cvtpk(P[BASE + 6], P[BASE + 7]);                              \
    auto r0 = __builtin_amdgcn_permlane32_swap(a0, b0, false, false); auto r1 = __builtin_amdgcn_permlane32_swap(a1, b1, false, false); \
    u32x4 w = {r0[0], r1[0], r0[1], r1[1]}; OUT = *reinterpret_cast<bf16x8*>(&w); } while (0)
  PK4(p0, 0, pa0); PK4(p0, 8, pa1); PK4(p1, 0, pa2); PK4(p1, 8, pa3);
#undef PK4
}
__device__ __forceinline__ void qkt(f32x16& p0, f32x16& p1, const bf16* Ks, const bf16x8* qr, int r32, int hi) {
  p0 = f32x16{}; p1 = f32x16{};
#pragma unroll
  for (int d0 = 0; d0 < 8; ++d0) { int cb = (d0 * 16 + hi * 8) * 2;
    bf16x8 b0 = *reinterpret_cast<const bf16x8*>((const char*)Ks + KSWZ(r32, cb));
    bf16x8 b1 = *reinterpret_cast<const bf16x8*>((const char*)Ks + KSWZ(32 + r32, cb));
    p0 = __builtin_amdgcn_mfma_f32_32x32x16_bf16(b0, qr[d0], p0, 0, 0, 0);
    p1 = __builtin_amdgcn_mfma_f32_32x32x16_bf16(b1, qr[d0], p1, 0, 0, 0); }
}
__device__ __forceinline__ int v_st(int k, int c) { const int kk = (k & ~0xC) | ((k & 4) << 1) | ((k & 8) >> 1); return ((kk >> 3) * 4 + (c >> 5)) * 512 + ((kk & 7) * 32 + (c & 31)) * 2; }
__device__ __forceinline__ int v_rd_base(int lane) { return ((lane & 3) << 3) | (((lane >> 2) & 3) << 6) | (((lane >> 4) & 1) << 5) | (((lane >> 5) & 1) << 8); }
constexpr int v_rd_off(int d0, int ks, int half) { return d0 * 512 + ks * 4096 + half * 2048; }
template <int OFF> __device__ __forceinline__ s16x4 tr_read(int vb) {
  s16x4 r; asm volatile("ds_read_b64_tr_b16 %0, %1 offset:%2" : "=&v"(r) : "v"(vb), "i"(OFF) : "memory"); return r;
}
template <int D0> __device__ __forceinline__ void pv_one(f32x16& od, int vb, bf16x8 pa0, bf16x8 pa1, bf16x8 pa2, bf16x8 pa3) {
  const s16x4 l0 = tr_read<v_rd_off(D0, 0, 0)>(vb), h0 = tr_read<v_rd_off(D0, 0, 1)>(vb), l1 = tr_read<v_rd_off(D0, 1, 0)>(vb), h1 = tr_read<v_rd_off(D0, 1, 1)>(vb);
  const s16x4 l2 = tr_read<v_rd_off(D0, 2, 0)>(vb), h2 = tr_read<v_rd_off(D0, 2, 1)>(vb), l3 = tr_read<v_rd_off(D0, 3, 0)>(vb), h3 = tr_read<v_rd_off(D0, 3, 1)>(vb);
  asm volatile("s_waitcnt lgkmcnt(0)" ::: "memory"); SBAR();
#define PK(L, H) (bf16x8){L[0], L[1], L[2], L[3], H[0], H[1], H[2], H[3]}
  od = __builtin_amdgcn_mfma_f32_32x32x16_bf16(pa0, PK(l0, h0), od, 0, 0, 0);
  od = __builtin_amdgcn_mfma_f32_32x32x16_bf16(pa1, PK(l1, h1), od, 0, 0, 0);
  od = __builtin_amdgcn_mfma_f32_32x32x16_bf16(pa2, PK(l2, h2), od, 0, 0, 0);
  od = __builtin_amdgcn_mfma_f32_32x32x16_bf16(pa3, PK(l3, h3), od, 0, 0, 0);
#undef PK
}
__device__ __forceinline__ void pv_d0(f32x16* o, int vb, bf16x8 pa0, bf16x8 pa1, bf16x8 pa2, bf16x8 pa3) {
  pv_one<0>(o[0], vb, pa0, pa1, pa2, pa3); pv_one<1>(o[1], vb, pa0, pa1, pa2, pa3); pv_one<2>(o[2], vb, pa0, pa1, pa2, pa3); pv_one<3>(o[3], vb, pa0, pa1, pa2, pa3);
}
__device__ __forceinline__ void attn_dense_body(const bf16* __restrict__ Qb, const bf16* __restrict__ Kh, const bf16* __restrict__ Vh,
                                                float* __restrict__ Ob, int seq, char* lds, int tid) {
  asm volatile("" : "+v"(tid));
  const int wid = __builtin_amdgcn_readfirstlane(tid >> 6), lane = tid & 63, r32 = lane & 31, hi = lane >> 5;
  bf16* V_lds = (bf16*)lds; bf16* K_lds = (bf16*)(lds + 2 * SHM_V);
  float* ws = (float*)(lds + 2 * SHM_V + 2 * SHM_K) + wid * 64; float* li_l = ws; float* al_l = ws + 32;
  float m_reg = -1e30f, l_reg = 0; f32x16 o[4] = {}; bf16x8 qr[8];
  const bf16* Qw = Qb + (long)(wid * QBLK + r32) * LDQ + hi * 8;
#pragma unroll
  for (int d0 = 0; d0 < 8; ++d0) qr[d0] = ld8(Qw + d0 * 16);
  const int sr = tid >> 4, sc = (tid & 15) * 8, vst0 = v_st(sr, sc), vst1 = v_st(32 + sr, sc);
  const int vb0 = (int)(uintptr_t)V_lds + v_rd_base(lane);
  struct { bf16x8 vs0, vs1, ks0, ks1; } sr_[2];
#define SLOAD(i, k0) do { sr_[i].vs0 = ld8(&Vh[(long)((k0) + sr) * LDK + sc]); sr_[i].vs1 = ld8(&Vh[(long)((k0) + 32 + sr) * LDK + sc]); \
    sr_[i].ks0 = ld8(&Kh[(long)((k0) + sr) * LDK + sc]); sr_[i].ks1 = ld8(&Kh[(long)((k0) + 32 + sr) * LDK + sc]); } while (0)
#define SWRITE(b, i) do { *(bf16x8*)((char*)V_lds + (b) * SHM_V + vst0) = sr_[i].vs0;          \
    *(bf16x8*)((char*)V_lds + (b) * SHM_V + vst1) = sr_[i].vs1; int kc = sc * 2;               \
    *(bf16x8*)((char*)K_lds + (b) * SHM_K + KSWZ(sr, kc)) = sr_[i].ks0;                       \
    *(bf16x8*)((char*)K_lds + (b) * SHM_K + KSWZ(32 + sr, kc)) = sr_[i].ks1; } while (0)
#define SWAIT() asm volatile("s_waitcnt vmcnt(4)" ::: "memory")
#define RESC(a) do { if (__any((a) < 1.f)) { if (hi == 0) al_l[r32] = (a); asm volatile("s_waitcnt lgkmcnt(0)" ::: "memory"); \
    _Pragma("unroll") for (int d = 0; d < 4; ++d) _Pragma("unroll") for (int r = 0; r < 16; ++r) o[d][r] *= al_l[crow(r, hi)]; } } while (0)
  f32x16 pA0, pA1, pB0, pB1; float mnA, mnB, alA, alB; bf16x8 pa0, pa1, pa2, pa3; const int NT = seq / KVBLK;
  constexpr int SE = 0, SO = 1;
  SLOAD(SE, 0); asm volatile("s_waitcnt vmcnt(0)" ::: "memory"); SWRITE(0, SE); __syncthreads();
  qkt(pA0, pA1, K_lds, qr, r32, hi); partialSM(pA0, pA1, m_reg, mnA, alA);
  SLOAD(SO, KVBLK); if (2 < NT) SLOAD(SE, 2 * KVBLK);
  SWAIT(); SWRITE(1, SO); __syncthreads();
  for (int j = 1; j + 1 < NT; j += 2) {
    SBAR(); qkt(pB0, pB1, (bf16*)((char*)K_lds + SHM_K), qr, r32, hi);
    finishSM(pA0, pA1, alA, l_reg, pa0, pa1, pa2, pa3); SBAR();
    SLOAD(SO, (j + 2) * KVBLK); SBAR();
    pv_d0(o, vb0, pa0, pa1, pa2, pa3); partialSM(pB0, pB1, m_reg, mnB, alB);
    __syncthreads(); SWAIT(); SWRITE(0, SE);
    RESC(alB); __syncthreads();
    SBAR(); qkt(pA0, pA1, K_lds, qr, r32, hi);
    finishSM(pB0, pB1, alB, l_reg, pa0, pa1, pa2, pa3); SBAR();
    if (j + 3 < NT) SLOAD(SE, (j + 3) * KVBLK); SBAR();
    pv_d0(o, vb0 + (int)SHM_V, pa0, pa1, pa2, pa3); partialSM(pA0, pA1, m_reg, mnA, alA);
    __syncthreads(); SWAIT(); SWRITE(1, SO);
    RESC(alA); __syncthreads();
  }
  SBAR(); qkt(pB0, pB1, (bf16*)((char*)K_lds + SHM_K), qr, r32, hi);
  finishSM(pA0, pA1, alA, l_reg, pa0, pa1, pa2, pa3); SBAR();
  pv_d0(o, vb0, pa0, pa1, pa2, pa3); partialSM(pB0, pB1, m_reg, mnB, alB);
  __syncthreads(); RESC(alB);
  finishSM(pB0, pB1, alB, l_reg, pa0, pa1, pa2, pa3); SBAR();
  pv_d0(o, vb0 + (int)SHM_V, pa0, pa1, pa2, pa3);
  if (hi == 0) li_l[r32] = l_reg; asm volatile("s_waitcnt lgkmcnt(0)" ::: "memory");
  float rli[16];
#pragma unroll
  for (int r = 0; r < 16; ++r) rli[r] = __builtin_amdgcn_rcpf(li_l[crow(r, hi)]);
  float* Ow = Ob + (long)(wid * QBLK) * LDO;
#pragma unroll
  for (int r = 0; r < 16; ++r) { int orow = crow(r, hi);
#pragma unroll
    for (int d0 = 0; d0 < 4; ++d0) Ow[(long)orow * LDO + d0 * 32 + r32] = o[d0][r] * rli[r]; }
  __syncthreads();
#undef SLOAD
#undef SWRITE
#undef SWAIT
#undef RESC
}

constexpr float QPRE = SCALE * 1.4426950408889634f;
constexpr float THR2 = THR * 1.4426950408889634f;
__device__ __forceinline__ void qkt2(f32x16& p0, f32x16& p1, const bf16* Ks, const bf16x8* qr, int r32, int hi, float negm) {
#pragma unroll
  for (int r = 0; r < 16; ++r) { p0[r] = negm; p1[r] = negm; }
#pragma unroll
  for (int d0 = 0; d0 < 8; ++d0) { int cb = (d0 * 16 + hi * 8) * 2;
    bf16x8 b0 = *reinterpret_cast<const bf16x8*>((const char*)Ks + KSWZ(r32, cb));
    bf16x8 b1 = *reinterpret_cast<const bf16x8*>((const char*)Ks + KSWZ(32 + r32, cb));
    p0 = __builtin_amdgcn_mfma_f32_32x32x16_bf16(b0, qr[d0], p0, 0, 0, 0);
    p1 = __builtin_amdgcn_mfma_f32_32x32x16_bf16(b1, qr[d0], p1, 0, 0, 0); }
}
__device__ __forceinline__ void partialSM2(f32x16& p0, f32x16& p1, float& m2, float& alpha) {
  float pmax = p0[0];
#pragma unroll
  for (int r = 1; r < 16; ++r) pmax = fmaxf(pmax, p0[r]);
#pragma unroll
  for (int r = 0; r < 16; ++r) pmax = fmaxf(pmax, p1[r]);
  { auto rr = __builtin_amdgcn_permlane32_swap(__float_as_uint(pmax), __float_as_uint(pmax), false, false);
    pmax = fmaxf(__uint_as_float(rr[0]), __uint_as_float(rr[1])); }
  if (__builtin_expect(__all(pmax <= THR2), 1)) { alpha = 1.f; }
  else { const float dl = fmaxf(pmax, 0.f); m2 += dl; alpha = __builtin_amdgcn_exp2f(-dl);
#pragma unroll
    for (int r = 0; r < 16; ++r) { p0[r] -= dl; p1[r] -= dl; } }
#pragma unroll
  for (int r = 0; r < 16; ++r) p0[r] = __builtin_amdgcn_exp2f(p0[r]);
}
constexpr int K8_BYTES = KVBLK * D * 2;
template <int ND> constexpr int v_rd_offn(int d0, int ks, int half) { return ((2 * ks + half) * ND + d0) * 512; }
template <int ND, int D0> __device__ __forceinline__ void pv_onen(f32x16& od, int vb, bf16x8 pa0, bf16x8 pa1, bf16x8 pa2, bf16x8 pa3) {
  const s16x4 l0 = tr_read<v_rd_offn<ND>(D0, 0, 0)>(vb), h0 = tr_read<v_rd_offn<ND>(D0, 0, 1)>(vb), l1 = tr_read<v_rd_offn<ND>(D0, 1, 0)>(vb), h1 = tr_read<v_rd_offn<ND>(D0, 1, 1)>(vb);
  const s16x4 l2 = tr_read<v_rd_offn<ND>(D0, 2, 0)>(vb), h2 = tr_read<v_rd_offn<ND>(D0, 2, 1)>(vb), l3 = tr_read<v_rd_offn<ND>(D0, 3, 0)>(vb), h3 = tr_read<v_rd_offn<ND>(D0, 3, 1)>(vb);
  asm volatile("s_waitcnt lgkmcnt(0)" ::: "memory"); SBAR();
#define PK(L, H) (bf16x8){L[0], L[1], L[2], L[3], H[0], H[1], H[2], H[3]}
  od = __builtin_amdgcn_mfma_f32_32x32x16_bf16(pa0, PK(l0, h0), od, 0, 0, 0);
  od = __builtin_amdgcn_mfma_f32_32x32x16_bf16(pa1, PK(l1, h1), od, 0, 0, 0);
  od = __builtin_amdgcn_mfma_f32_32x32x16_bf16(pa2, PK(l2, h2), od, 0, 0, 0);
  od = __builtin_amdgcn_mfma_f32_32x32x16_bf16(pa3, PK(l3, h3), od, 0, 0, 0);
#undef PK
}
template <int ND, class Side>
__device__ __forceinline__ void attn_dma_body(const bf16* __restrict__ Qb, const bf16* __restrict__ Kh, const bf16* __restrict__ Vh,
                                              float* __restrict__ Ob, int seq, LAS unsigned char* lds3, int tid, const Side& side) {
  constexpr int VB = KVBLK * ND * 32 * 2;
  asm volatile("" : "+v"(tid));
  const int wid = __builtin_amdgcn_readfirstlane(tid >> 6), lane = tid & 63, r32 = lane & 31, hi = lane >> 5;
  char* lds = (char*)lds3;
  bf16* K_lds = (bf16*)lds;
  float* ws = (float*)(lds + 3 * K8_BYTES + 3 * VB) + wid * 64; float* li_l = ws; float* al_l = ws + 32;
  float m_reg = 0.f  , l_reg = 0; f32x16 o[ND] = {}; bf16x8 qr[8];
  const bf16* Qw = Qb + (long)(wid * QBLK + r32) * LDQ + hi * 8;
#pragma unroll
  for (int d0 = 0; d0 < 8; ++d0) qr[d0] = ld8(Qw + d0 * 16);
  unsigned koff[2];
#pragma unroll
  for (int i = 0; i < 2; ++i) { const int row = 4 * (2 * wid + i) + (lane >> 4), lc = (lane & 15) ^ (row & 7); koff[i] = (unsigned)(row * LDK + lc * 8) * 2u; }
  unsigned voff;
  { const int kk = 8 * wid + ((lane & 31) >> 2), k = (kk & ~0xC) | ((kk & 4) << 1) | ((kk & 8) >> 1);
    voff = (unsigned)(k * LDK + (lane >> 5) * 32 + (lane & 3) * 8) * 2u; }
  const int vb0 = (int)(uintptr_t)(lds + 3 * K8_BYTES) + v_rd_base(lane);
#define DMA_TILE(t, b) do { const size_t go_ = (size_t)(t) * KVBLK * LDK * 2; const char* kb_ = (const char*)Kh + go_; const char* vb_ = (const char*)Vh + go_; \
    _Pragma("unroll") for (int i_ = 0; i_ < 2; ++i_) __builtin_amdgcn_global_load_lds((const unsigned*)(kb_ + koff[i_]), (LAS unsigned*)(lds3 + (b) * K8_BYTES + (2 * wid + i_) * 1024), 16, 0, 0); \
    _Pragma("unroll") for (int i_ = 0; i_ < ND / 2; ++i_) __builtin_amdgcn_global_load_lds((const unsigned*)(vb_ + i_ * 128 + voff), (LAS unsigned*)(lds3 + 3 * K8_BYTES + (b) * VB + ((ND / 2) * wid + i_) * 1024), 16, 0, 0); } while (0)
#define RESCN(a) do { if (__any((a) < 1.f)) { if (hi == 0) al_l[r32] = (a); asm volatile("s_waitcnt lgkmcnt(0)" ::: "memory"); \
    _Pragma("unroll") for (int d = 0; d < ND; ++d) _Pragma("unroll") for (int r = 0; r < 16; ++r) o[d][r] *= al_l[crow(r, hi)]; } } while (0)
  const int NT = seq / KVBLK;
  DMA_TILE(0, 0); DMA_TILE(1, 1);
  asm volatile("s_waitcnt vmcnt(0)" ::: "memory"); __syncthreads();
  int b = 0, bn2 = 2;
  float sv[8]; bf16_t* sdst = nullptr; bool shave = false;
  for (int j = 0; j < NT; ++j) {
    f32x16 p0, p1; float mn, al; bf16x8 pa0, pa1, pa2, pa3;
    SBAR(); qkt2(p0, p1, (bf16*)((char*)K_lds + b * K8_BYTES), qr, r32, hi, -m_reg); SBAR();
    asm volatile("s_waitcnt vmcnt(0)" ::: "memory");
    if (shave) side.finish(sv, sdst);
    { const float* ssrc; int sld; shave = side.addr(j, lane, ssrc, sld, sdst); if (shave) cvt_load8(sv, ssrc, sld); }
    if (j + 2 < NT) DMA_TILE(j + 2, bn2);
    partialSM2(p0, p1, m_reg, al);
    RESCN(al);
    finishSM(p0, p1, al, l_reg, pa0, pa1, pa2, pa3); SBAR();
    { const int vb = vb0 + b * VB;
      pv_onen<ND, 0>(o[0], vb, pa0, pa1, pa2, pa3); pv_onen<ND, 1>(o[1], vb, pa0, pa1, pa2, pa3); pv_onen<ND, 2>(o[2], vb, pa0, pa1, pa2, pa3); pv_onen<ND, 3>(o[3], vb, pa0, pa1, pa2, pa3);
      if constexpr (ND == 8) { pv_onen<ND, 4>(o[4], vb, pa0, pa1, pa2, pa3); pv_onen<ND, 5>(o[5], vb, pa0, pa1, pa2, pa3); pv_onen<ND, 6>(o[6], vb, pa0, pa1, pa2, pa3); pv_onen<ND, 7>(o[7], vb, pa0, pa1, pa2, pa3); } }
    asm volatile("s_waitcnt lgkmcnt(0)\n\ts_barrier" ::: "memory");
    bn2 = b; b = (b == 2) ? 0 : b + 1;
  }
  if (shave) { asm volatile("s_waitcnt vmcnt(0)" ::: "memory"); side.finish(sv, sdst); }
  if (hi == 0) li_l[r32] = l_reg; asm volatile("s_waitcnt lgkmcnt(0)" ::: "memory");
  float rli[16];
#pragma unroll
  for (int r = 0; r < 16; ++r) rli[r] = __builtin_amdgcn_rcpf(li_l[crow(r, hi)]);
  float* Ow = Ob + (long)(wid * QBLK) * LDO;
#pragma unroll
  for (int r = 0; r < 16; ++r) { int orow = crow(r, hi);
#pragma unroll
    for (int d0 = 0; d0 < ND; ++d0) Ow[(long)orow * LDO + d0 * 32 + r32] = o[d0][r] * rli[r]; }
  __syncthreads();
#undef DMA_TILE
#undef RESCN
}
#undef SBAR
}

struct Args { const float* in[29]; float* out; unsigned char* ws; int ph_lo, ph_hi, one_launch, pad; };
typedef const __attribute__((address_space(4))) Args* KArgs;
struct Frame {
    LAS unsigned char* lds;
    volatile LAS unsigned* MISC;
    unsigned* ctl;
    int tid, lane, wave, vcu, G;
    KArgs ap;
    float* out; unsigned char* ws;
};
#define INP(i) (F.ap->in[i])
#define RELAUNDER() do { asm volatile("" : "+s"(F.ap)); F.lane = lane_id_v(); F.tid = F.wave * 64 + F.lane; } while (0)
enum { I_X = 0, I_C, I_CTX, I_CCTX, I_WADA, I_BADA, I_NMIX, I_NFFN, I_WIN, I_QNA, I_KNA, I_QNB, I_KNB, I_LQ1, I_LK1, I_LQ2, I_LK2, I_SUBLN, I_WA, I_WB, I_WO, I_WR, I_RB, I_WEG, I_WEU, I_WED, I_WSG, I_WSU, I_WSD };

__device__ __forceinline__ f32x4 load_mod4(const Frame& F, int v, int j, int k) {
    return *(const f32x4*)((const float*)(F.ws + WS_MOD) + (size_t)v * (NMOD * DM) + j * DM + k);
}

__device__ __forceinline__ void cvt_load8(float (&v)[8], const float* src, int ld) {
#pragma unroll
    for (int j = 0; j < 8; ++j) v[j] = __builtin_nontemporal_load(src + (size_t)j * ld);
}
__device__ __forceinline__ void cvt_store8(const float (&v)[8], bf16_t* dst) {
    u32x4 o; o.x = pk2(v[0], v[1]); o.y = pk2(v[2], v[3]); o.z = pk2(v[4], v[5]); o.w = pk2(v[6], v[7]);
    __builtin_nontemporal_store(o, (u32x4*)dst);
}
constexpr int XJ_PER = 2048, XJ_TOTAL = 3 * 65 * XJ_PER;
__device__ __forceinline__ void xjob_decode(const Frame& F, int J, int lane, const float*& src, int& ld, bf16_t*& dst) {
    const int type = J / (65 * XJ_PER), r = J - type * (65 * XJ_PER), e = r / XJ_PER, q = r % XJ_PER;
    if (type < 2) { const int kc = q >> 3, n = (q & 7) * 64 + lane;
        const float* base = (e < 64) ? INP(type ? I_WEU : I_WEG) + (size_t)e * DM * FE : INP(type ? I_WSU : I_WSG);
        src = base + (size_t)(8 * kc) * FE + n; ld = FE;
        const int np = (n >> 7) * 256 + type * 128 + (n & 127);
        dst = (bf16_t*)(F.ws + WS_WGU + (size_t)e * GU_BYTES) + ((size_t)kc * NP_GU + np) * 8;
    } else { const int kc = q >> 5, n = (q & 31) * 64 + lane;
        const float* base = (e < 64) ? INP(I_WED) + (size_t)e * FE * DM : INP(I_WSD);
        src = base + (size_t)(8 * kc) * DM + n; ld = DM;
        dst = (bf16_t*)(F.ws + WS_WD + (size_t)e * D_BYTES) + ((size_t)kc * NP_D + n) * 8;
    }
}

struct NoSide { __device__ __forceinline__ bool addr(int, int, const float*&, int&, bf16_t*&) const { return false; }
                __device__ __forceinline__ void finish(const float (&)[8], bf16_t*) const {} };
struct XcvtSide { const Frame* F; int step0;
    __device__ __forceinline__ bool addr(int j, int lane, const float*& src, int& ld, bf16_t*& dst) const {
        const int J = ((step0 + j) * F->G + F->vcu) * NWAVES + F->wave; if (J >= XJ_TOTAL) return false;
        xjob_decode(*F, J, lane, src, ld, dst); return true; }
    __device__ __forceinline__ void finish(const float (&v)[8], bf16_t* dst) const { cvt_store8(v, dst); } };

__device__ __forceinline__ void p0_prologue(Frame& F) {
    const int gw = F.vcu * NWAVES + F.wave, NGW = F.G * NWAVES;
    bf16_t* Win = (bf16_t*)(F.ws + WS_WIN); bf16_t* Wab = (bf16_t*)(F.ws + WS_WAB); bf16_t* Wo = (bf16_t*)(F.ws + WS_WO);
    constexpr int J_IN = 256 * (INW / 64), J_AB = 256 * (DM / 64), J_O = 256 * (DM / 64), NJ = J_IN + J_AB + J_O;
#if !P0_EXPERTS
    constexpr int NJ_ALL = NJ;
#else
    constexpr int NJ_ALL = NJ + XJ_TOTAL;
#endif
    for (int it = gw; it < NJ_ALL; it += 2 * NGW) {
        const float* src[2]; int ld[2]; bf16_t* dst[2]; bool ok[2];
#pragma unroll
        for (int h = 0; h < 2; ++h) { int r = it + h * NGW; ok[h] = r < NJ_ALL; if (!ok[h]) r = it;
            if (r < J_IN) { const int kc = r / (INW / 64), n = (r % (INW / 64)) * 64 + F.lane; const int nsrc = is_qk_col(n) ? (n & ~127) + rope_e(n & 127) : n;
                src[h] = INP(I_WIN) + (size_t)(8 * kc) * INW + nsrc; ld[h] = INW; dst[h] = Win + ((size_t)kc * INW + n) * 8; }
            else if (r < J_IN + J_AB) { r -= J_IN; const int kc = r >> 5, n = (r & 31) * 64 + F.lane;
                src[h] = (kc < 128 ? INP(I_WA) + (size_t)(8 * kc) * DM : INP(I_WB) + (size_t)(8 * (kc - 128)) * DM) + n; ld[h] = DM; dst[h] = Wab + ((size_t)kc * DM + n) * 8; }
            else if (r < NJ) { r -= J_IN + J_AB; const int kc = r >> 5, n = (r & 31) * 64 + F.lane; src[h] = INP(I_WO) + (size_t)(8 * kc) * DM + n; ld[h] = DM; dst[h] = Wo + ((size_t)kc * DM + n) * 8; }
            else { xjob_decode(F, r - NJ, F.lane, src[h], ld[h], dst[h]); } }
        float v0[8], v1[8]; cvt_load8(v0, src[0], ld[0]); cvt_load8(v1, src[1], ld[1]);
        cvt_store8(v0, dst[0]); if (ok[1]) cvt_store8(v1, dst[1]);
    }
    { bf16_t* whi = (bf16_t*)(F.ws + WS_WRHI); bf16_t* wlo = (bf16_t*)(F.ws + WS_WRLO);
      for (int idx = (F.vcu * NTHREADS + F.tid); idx < DM * NE; idx += F.G * NTHREADS) { const int k = idx >> 6, n = idx & 63;
          const float w = INP(I_WR)[idx]; const unsigned h = f2bf(w); const float rem = w - __uint_as_float(h << 16);
          whi[n * DM + k] = (bf16_t)h; wlo[n * DM + k] = (bf16_t)f2bf(rem); } }
    { f32x2* cs = (f32x2*)(F.ws + WS_CS);
      for (int idx = (F.vcu * NTHREADS + F.tid); idx < SEQ * 64; idx += F.G * NTHREADS) { const int t = idx >> 6, pi = idx & 63, i = pi & 31;
          const float inv = exp2f(-(float)i * (13.287712379549449f / 32.0f)); const float pos = (pi < 32) ? (float)(t >> 6) : (float)(t & 63); const float a = pos * inv;
          cs[idx] = (f32x2){cosf(a), sinf(a)}; } }
    __syncthreads();
    if (blockIdx.x < 192) {
        const int cb = blockIdx.x % 48, kq = blockIdx.x / 48;
        const float* wada = INP(I_WADA) + cb * 256 + 4 * F.lane;
        const int kbase = kq * 512 + F.wave * 64;
        f32x4 a0 = {0.f, 0.f, 0.f, 0.f}, a1 = {0.f, 0.f, 0.f, 0.f};
#pragma unroll 8
        for (int j = 0; j < 64; ++j) { const int k = kbase + j;
            const float c0 = INP(I_C)[k], c1 = INP(I_CCTX)[k];
            const float s0 = c0 * sigmoidf_(c0), s1 = c1 * sigmoidf_(c1);
            const f32x4 w = *(const f32x4*)(wada + (size_t)k * (NMOD * DM));
            a0 = a0 + w * s0; a1 = a1 + w * s1; }
        LAS f32x4* red = (LAS f32x4*)F.lds;
        red[(F.wave * 2 + 0) * 64 + F.lane] = a0; red[(F.wave * 2 + 1) * 64 + F.lane] = a1;
        LDS_WAIT(); __syncthreads();
        { const int v = F.tid >> 8, col = F.tid & 255; const LAS float* rf = (const LAS float*)F.lds; float s = 0.f;
#pragma unroll
          for (int w = 0; w < 8; ++w) s += rf[((w * 2 + v) * 64 + (col >> 2)) * 4 + (col & 3)];
          float* modp = (float*)(F.ws + WS_MODP);
          modp[(size_t)(kq * 2 + v) * (NMOD * DM) + cb * 256 + col] = s; }
        __threadfence(); __syncthreads();
        LAS unsigned* flg = (LAS unsigned*)(F.lds + 32768);
        if (F.tid == 0) { const unsigned old = __hip_atomic_fetch_add(F.ctl + CW_ADA + cb, 1u, __ATOMIC_ACQ_REL, __HIP_MEMORY_SCOPE_AGENT); flg[0] = (old == 3u) ? 1u : 0u; }
        LDS_WAIT(); __syncthreads();
        if (flg[0]) { __threadfence();
            const int v = F.tid >> 8, col = cb * 256 + (F.tid & 255); const float* modp = (const float*)(F.ws + WS_MODP);
            float s = INP(I_BADA)[col];
#pragma unroll
            for (int q = 0; q < 4; ++q) s += __hip_atomic_load(modp + (size_t)(q * 2 + v) * (NMOD * DM) + col, __ATOMIC_RELAXED, __HIP_MEMORY_SCOPE_AGENT);
            ((float*)(F.ws + WS_MOD))[(size_t)v * (NMOD * DM) + col] = s; }
        __syncthreads();
    }
}

template <bool SPLIT>
__device__ __forceinline__ void norm_mod_rows(Frame& F, int rbeg, int rend, int rstep, const float* gain, int jshift, bf16_t* ohi, bf16_t* olo, bool ctx_first) {
    f32x4 Am[8], Bm[8]; int curv = -1;
    for (int r = rbeg; r < rend; r += rstep) {
        const int v = (ctx_first && r < CTXL) ? 1 : 0;
        if (v != curv) { curv = v;
#pragma unroll
            for (int j = 0; j < 8; ++j) { const int k = 4 * F.lane + 256 * j; const f32x4 g = *(const f32x4*)(gain + k);
                const f32x4 sh = load_mod4(F, v, jshift, k), sc = load_mod4(F, v, jshift + 1, k);
                Am[j] = g * (sc + 1.0f); Bm[j] = sh; } }
        const float* src = ctx_first ? (r < CTXL ? INP(I_CTX) + (size_t)r * DM : INP(I_X) + (size_t)(r - CTXL) * DM) : (const float*)(F.ws + WS_X1) + (size_t)r * DM;
        f32x4 x[8]; float ss = 0.f;
#pragma unroll
        for (int j = 0; j < 8; ++j) { x[j] = *(const f32x4*)(src + 4 * F.lane + 256 * j); ss += (x[j][0] * x[j][0] + x[j][1] * x[j][1]) + (x[j][2] * x[j][2] + x[j][3] * x[j][3]); }
        const float rstd = 1.0f / sqrtf(wave_sum(ss) * (1.0f / DM) + EPS);
#pragma unroll
        for (int j = 0; j < 8; ++j) { const f32x4 h = (x[j] * rstd) * Am[j] + Bm[j];
            const unsigned w0 = pk2(h[0], h[1]), w1 = pk2(h[2], h[3]);
            u32x2 o; o.x = w0; o.y = w1; *(u32x2*)(ohi + (size_t)r * DM + 4 * F.lane + 256 * j) = o;
            if (SPLIT) { u32x2 l; l.x = pk2(h[0] - bflo(w0), h[1] - bfhi(w0)); l.y = pk2(h[2] - bflo(w1), h[3] - bfhi(w1)); *(u32x2*)(olo + (size_t)r * DM + 4 * F.lane + 256 * j) = l; } }
    }
}

__device__ __forceinline__ void p3_headnorm_rope(Frame& F) {
    const int gw = F.vcu * NWAVES + F.wave, NGW = F.G * NWAVES;
    bf16_t* P = (bf16_t*)(F.ws + WS_P);
    const int e0 = 2 * F.lane;
    const int i0 = e0 & 31;
    const float inv0 = exp2f(-(float)i0 * (13.287712379549449f / 32.0f)), inv1 = exp2f(-(float)(i0 + 1) * (13.287712379549449f / 32.0f));
    const bool second = (F.lane & 16) != 0;
    const f32x2 gq_a = *(const f32x2*)(INP(I_QNA) + e0), gk_a = *(const f32x2*)(INP(I_KNA) + e0), gq_b = *(const f32x2*)(INP(I_QNB) + e0), gk_b = *(const f32x2*)(INP(I_KNB) + e0);
#define P3_COL(hh) ((hh) < 8 ? C_AQ + (hh) * 128 : (hh) < 10 ? C_AK + ((hh) - 8) * 128 : (hh) < 18 ? C_BQ + ((hh) - 10) * 128 : C_BK + ((hh) - 18) * 128)
#define P3_ISQ(hh) ((hh) < 8 || ((hh) >= 10 && (hh) < 18))
    for (int r = gw; r < MT; r += NGW) {
        const bool lat = r >= CTXL;
        float c0 = 1.f, s0 = 0.f, c1 = 1.f, s1 = 0.f;
        if (lat) { const int t = r - CTXL; const float pos = (F.lane < 32) ? (float)(t >> 6) : (float)(t & 63);
            const float a0 = pos * inv0, a1 = pos * inv1; c0 = cosf(a0); s0 = sinf(a0); c1 = cosf(a1); s1 = sinf(a1); }
        unsigned* prow = (unsigned*)(P + (size_t)r * INW + e0);
        unsigned w[26];
#pragma unroll
        for (int hh = 0; hh < 26; ++hh) { w[hh] = 0u; if (lat || !P3_ISQ(hh)) w[hh] = prow[P3_COL(hh) / 2]; }
#pragma unroll
        for (int hh = 0; hh < 26; ++hh) {
            if (!lat && P3_ISQ(hh)) continue;
            const f32x2 g = hh < 8 ? gq_a : hh < 10 ? gk_a : hh < 18 ? gq_b : gk_b;
            float x0 = bflo(w[hh]), x1 = bfhi(w[hh]);
            const float ss = wave_sum(x0 * x0 + x1 * x1);
            const float rstd = 1.0f / sqrtf(ss * (1.0f / 128.0f) + EPS);
            x0 = x0 * rstd * g[0]; x1 = x1 * rstd * g[1];
            if (lat) { const float y0 = __shfl_xor(x0, 16), y1 = __shfl_xor(x1, 16);
                if (!second) { x0 = x0 * c0 - y0 * s0; x1 = x1 * c1 - y1 * s1; } else { x0 = y0 * s0 + x0 * c0; x1 = y1 * s1 + x1 * c1; } }
            prow[P3_COL(hh) / 2] = pk2(x0, x1);
        }
    }
#undef P3_COL
#undef P3_ISQ
}

__device__ __forceinline__ void p5_combine(Frame& F) {
    const int gw = F.vcu * NWAVES + F.wave, NGW = F.G * NWAVES;
    float d1 = INP(I_LQ1)[F.lane] * INP(I_LK1)[F.lane] + INP(I_LQ1)[F.lane + 64] * INP(I_LK1)[F.lane + 64];
    float d2 = INP(I_LQ2)[F.lane] * INP(I_LK2)[F.lane] + INP(I_LQ2)[F.lane + 64] * INP(I_LK2)[F.lane + 64];
    d1 = wave_sum(d1); d2 = wave_sum(d2);
    const float lam_init = 0.2f;
    const float lam = expf(d1) - expf(d2) + lam_init;
    const float* OA = (const float*)(F.ws + WS_OA); const float* OB0 = (const float*)(F.ws + WS_OB0); const float* OB1 = (const float*)(F.ws + WS_OB1);
    bf16_t* A2 = (bf16_t*)(F.ws + WS_A2);
    const f32x4 sg = *(const f32x4*)(INP(I_SUBLN) + 4 * F.lane);
    for (int t = gw; t < SEQ; t += NGW) {
#pragma unroll
        for (int j = 0; j < 4; ++j) { const f32x4 a = *(const f32x4*)(OA + (size_t)t * 1024 + 4 * F.lane + 256 * j);
            u32x2 o; o.x = pk2(a[0], a[1]); o.y = pk2(a[2], a[3]); *(u32x2*)(A2 + (size_t)t * DM + 4 * F.lane + 256 * j) = o; }
#pragma unroll
        for (int h = 0; h < 4; ++h) { const f32x4 u0 = *(const f32x4*)(OB0 + (size_t)t * 1024 + h * 256 + 4 * F.lane), u1 = *(const f32x4*)(OB1 + (size_t)t * 1024 + h * 256 + 4 * F.lane);
            const f32x4 d = u0 - u1 * lam;
            const float ss = wave_sum((d[0] * d[0] + d[1] * d[1]) + (d[2] * d[2] + d[3] * d[3]));
            const float rstd = 1.0f / sqrtf(ss * (1.0f / 256.0f) + EPS);
            const f32x4 y = (d * rstd) * sg * (1.0f - lam_init);
            u32x2 o; o.x = pk2(y[0], y[1]); o.y = pk2(y[2], y[3]); *(u32x2*)(A2 + (size_t)t * DM + 1024 + h * 256 + 4 * F.lane) = o; }
    }
}

__device__ __forceinline__ void p10_router(Frame& F) {
    const bf16_t* Hhi = (const bf16_t*)(F.ws + WS_H2HI); const bf16_t* Hlo = (const bf16_t*)(F.ws + WS_H2LO);
    const bf16_t* Whi = (const bf16_t*)(F.ws + WS_WRHI); const bf16_t* Wlo = (const bf16_t*)(F.ws + WS_WRLO);
    int* tokE = (int*)(F.ws + WS_TOKE); int* tokS = (int*)(F.ws + WS_TOKS); float* tokW = (float*)(F.ws + WS_TOKW); int* list = (int*)(F.ws + WS_LIST);
    unsigned* cnt = F.ctl + CW_CNT;
    LAS float* part = (LAS float*)F.lds;
    LAS float* logit = (LAS float*)(F.lds + 65536);
    LAS float* score = (LAS float*)(F.lds + 65536 + 32 * 65 * 4);
    const int r32 = F.lane & 31, hi = F.lane >> 5;
    for (int u = F.vcu; u < SEQ / 32; u += F.G) {
        const int row0 = u * 32;
        norm_mod_rows<true>(F, row0 + F.wave * 4, row0 + F.wave * 4 + 4, 1, INP(I_NFFN), 3, (bf16_t*)(F.ws + WS_H2HI), (bf16_t*)(F.ws + WS_H2LO), false);
        VM_WAIT(); __syncthreads(); __builtin_amdgcn_fence(__ATOMIC_ACQUIRE, "agent"); VM_WAIT();
        f32x16 acc0 = {}, acc1 = {};
        const int kb = F.wave * 256 + hi * 8;
#pragma unroll 4
        for (int s = 0; s < 16; ++s) { const int k = kb + 16 * s;
            const bf16x8 ah = *(const bf16x8*)(Hhi + (size_t)(row0 + r32) * DM + k), al = *(const bf16x8*)(Hlo + (size_t)(row0 + r32) * DM + k);
            const bf16x8 b0h = *(const bf16x8*)(Whi + (size_t)r32 * DM + k), b0l = *(const bf16x8*)(Wlo + (size_t)r32 * DM + k);
            const bf16x8 b1h = *(const bf16x8*)(Whi + (size_t)(32 + r32) * DM + k), b1l = *(const bf16x8*)(Wlo + (size_t)(32 + r32) * DM + k);
            acc0 = __builtin_amdgcn_mfma_f32_32x32x16_bf16(al, b0h, acc0, 0, 0, 0); acc0 = __builtin_amdgcn_mfma_f32_32x32x16_bf16(ah, b0l, acc0, 0, 0, 0); acc0 = __builtin_amdgcn_mfma_f32_32x32x16_bf16(ah, b0h, acc0, 0, 0, 0);
            acc1 = __builtin_amdgcn_mfma_f32_32x32x16_bf16(al, b1h, acc1, 0, 0, 0); acc1 = __builtin_amdgcn_mfma_f32_32x32x16_bf16(ah, b1l, acc1, 0, 0, 0); acc1 = __builtin_amdgcn_mfma_f32_32x32x16_bf16(ah, b1h, acc1, 0, 0, 0); }
#pragma unroll
        for (int r = 0; r < 16; ++r) { const int row = attn::crow(r, hi); part[(F.wave * 32 + row) * 64 + r32] = acc0[r]; part[(F.wave * 32 + row) * 64 + 32 + r32] = acc1[r]; }
        LDS_WAIT(); __syncthreads();
        {
            const int row = F.tid >> 4, q = F.tid & 15, e4 = q * 4, t = row0 + row; f32x4 s = {0.f, 0.f, 0.f, 0.f};
#pragma unroll
            for (int w = 0; w < 8; ++w) s = s + *(const LAS f32x4*)(part + (w * 32 + row) * 64 + e4);
            LAS float* bs = logit + row * 65;
            float sc[4], bv[4];
#pragma unroll
            for (int j = 0; j < 4; ++j) { sc[j] = sigmoidf_(s[j]); bv[j] = sc[j] + INP(I_RB)[e4 + j]; bs[e4 + j] = bv[j]; }
            float m1 = fmaxf(bv[0], bv[1]), m2 = fminf(bv[0], bv[1]);
            { const float a = fmaxf(bv[2], bv[3]), b = fminf(bv[2], bv[3]); const float n1 = fmaxf(m1, a); m2 = fmaxf(fminf(m1, a), fmaxf(m2, b)); m1 = n1; }
            { const float p1 = __shfl_xor(m1, 1), p2 = __shfl_xor(m2, 1); const float n1 = fmaxf(m1, p1); m2 = fmaxf(fminf(m1, p1), fmaxf(m2, p2)); m1 = n1; }
            const float gs = m1 + m2;
            float gsv[8];
#pragma unroll
            for (int g = 0; g < 8; ++g) gsv[g] = __shfl(gs, (F.lane & 48) + 2 * g);
            unsigned gmask = 0u;
#pragma unroll
            for (int g = 0; g < 8; ++g) { int rk = 0;
#pragma unroll
                for (int h = 0; h < 8; ++h) rk += (gsv[h] > gsv[g] || (gsv[h] == gsv[g] && h < g)) ? 1 : 0;
                gmask |= (rk < 4) ? (1u << g) : 0u; }
            LDS_WAIT(); __syncthreads();
            const bool mysel = (gmask >> (q >> 1)) & 1u;
            int rk[4] = {0, 0, 0, 0};
            if (mysel) {
                for (int e = 0; e < 64; ++e) { if (!((gmask >> (e >> 3)) & 1u)) continue; const float v = bs[e];
#pragma unroll
                    for (int j = 0; j < 4; ++j) rk[j] += (v > bv[j] || (v == bv[j] && e < e4 + j)) ? 1 : 0; } }
            float ssum = 0.f;
#pragma unroll
            for (int j = 0; j < 4; ++j) ssum += (mysel && rk[j] < 8) ? sc[j] : 0.f;
            ssum += __shfl_xor(ssum, 1); ssum += __shfl_xor(ssum, 2); ssum += __shfl_xor(ssum, 4); ssum += __shfl_xor(ssum, 8);
            const float inv = 2.5f / ssum;
#pragma unroll
            for (int j = 0; j < 4; ++j) if (mysel && rk[j] < 8) { const int e = e4 + j, k = rk[j];
                const unsigned slot = __hip_atomic_fetch_add(cnt + e, 1u, RLX_AGENT);
                list[e * SEQ + (int)slot] = t; tokE[t * 8 + k] = e; tokS[t * 8 + k] = (int)slot; tokW[t * 8 + k] = sc[j] * inv; }
        }
        __syncthreads();
    }
}

__device__ __forceinline__ void moe_tables(Frame& F) {
    LAS int* tab = (LAS int*)(F.lds + TAB_OFF);
    __syncthreads();
    if (F.tid == 0) { int off = 0;
        for (int e = 0; e < 64; ++e) { int c = (int)__hip_atomic_load(F.ctl + CW_CNT + e, RLX_AGENT); c = c < 0 ? 0 : (c > SEQ ? SEQ : c); tab[e] = c; tab[65 + e] = off; off += (c + 255) >> 8; }
        if (off > SH_TILE0) off = SH_TILE0;
        tab[64] = SEQ; tab[65 + 64] = off; tab[65 + 65] = off + 32; }
    LDS_WAIT(); __syncthreads();
}

__device__ __forceinline__ void fp8x16_fma(f32x4 (&a)[4], const u32x4 w, float sc) {
#pragma unroll
    for (int q = 0; q < 4; ++q) { const int x = (int)w[q];
        a[q][0] += sc * __builtin_amdgcn_cvt_f32_fp8(x, 0); a[q][1] += sc * __builtin_amdgcn_cvt_f32_fp8(x, 1); a[q][2] += sc * __builtin_amdgcn_cvt_f32_fp8(x, 2); a[q][3] += sc * __builtin_amdgcn_cvt_f32_fp8(x, 3); }
}
__device__ __forceinline__ void p13_final(Frame& F) {
    const int gw = F.vcu * NWAVES + F.wave, NGW = F.G * NWAVES;
    const LAS int* toff = (const LAS int*)(F.lds + TAB_OFF) + 65;
    const int* tokE = (const int*)(F.ws + WS_TOKE); const int* tokS = (const int*)(F.ws + WS_TOKS); const float* tokW = (const float*)(F.ws + WS_TOKW);
    const unsigned char* Y = (const unsigned char*)(F.ws + WS_YROWS); const float* X1 = (const float*)(F.ws + WS_X1);
    f32x4 g5[2][4];
#pragma unroll
    for (int j = 0; j < 2; ++j)
#pragma unroll
        for (int q = 0; q < 4; ++q) g5[j][q] = load_mod4(F, 0, 5, 16 * F.lane + 1024 * j + 4 * q);
    for (int t = gw; t < SEQ; t += NGW) {
        f32x4 a[2][4];
#pragma unroll
        for (int j = 0; j < 2; ++j)
#pragma unroll
            for (int q = 0; q < 4; ++q) a[j][q] = (f32x4){0.f, 0.f, 0.f, 0.f};
        { const unsigned char* yr = Y + ((size_t)SH_TILE0 * 256 + t) * DM + 16 * F.lane;
#pragma unroll
          for (int j = 0; j < 2; ++j) fp8x16_fma(a[j], *(const u32x4*)(yr + 1024 * j), 1.0f / 32.0f); }
#pragma unroll
        for (int k = 0; k < 8; ++k) {
            const int e = __builtin_amdgcn_readfirstlane(tokE[t * 8 + k]), sl = __builtin_amdgcn_readfirstlane(tokS[t * 8 + k]);
            const float wk = __uint_as_float(__builtin_amdgcn_readfirstlane(__float_as_uint(tokW[t * 8 + k]))) * (1.0f / 32.0f);
            const int ee = (e < 0 || e > 63) ? 0 : e;
            const unsigned char* yr = Y + ((size_t)toff[ee] * 256 + sl) * DM + 16 * F.lane;
#pragma unroll
            for (int j = 0; j < 2; ++j) fp8x16_fma(a[j], *(const u32x4*)(yr + 1024 * j), wk);
        }
#pragma unroll
        for (int j = 0; j < 2; ++j)
#pragma unroll
            for (int q = 0; q < 4; ++q) { const size_t o = (size_t)t * DM + 16 * F.lane + 1024 * j + 4 * q;
                *(f32x4*)(F.out + o) = *(const f32x4*)(X1 + o) + g5[j][q] * a[j][q]; }
    }
}

__device__ __forceinline__ void stagger(const Frame& F, unsigned ticks_per_step) {
    const unsigned long long t0 = __builtin_amdgcn_s_memrealtime(); const unsigned long long want = (unsigned long long)((blockIdx.x >> 3) & 31u) * ticks_per_step;
    while (__builtin_amdgcn_s_memrealtime() - t0 < want) __builtin_amdgcn_s_sleep(4);
}

constexpr int N_PHASES = 14;
__global__ void __launch_bounds__(NTHREADS, 2) mk_fwd(Args args) {
    extern __shared__ __attribute__((aligned(16))) unsigned char lds[];
    Frame F;
    F.lds = (LAS unsigned char*)lds;
    F.MISC = (volatile LAS unsigned*)(F.lds + MISC_OFF);
    F.tid = threadIdx.x; F.lane = F.tid & 63; F.wave = __builtin_amdgcn_readfirstlane(F.tid >> 6);
    F.G = gridDim.x; { const int bx = blockIdx.x; F.vcu = (F.G % 8 == 0) ? (bx % 8) * (F.G / 8) + bx / 8 : bx; }
    F.ws = args.ws; F.ctl = (unsigned*)(args.ws + WS_CTL); F.out = args.out;
    F.ap = (KArgs)__builtin_amdgcn_kernarg_segment_ptr();
    for (int u = F.tid; u < (LDS_BYTES - LDSCTL_OFF) / 4; u += NTHREADS) ((LAS unsigned*)(F.lds + LDSCTL_OFF))[u] = 0u;
    __syncthreads();
    XcdBarrier bar; bar.bar = F.ctl + CW_BAR; bar.x = 0; bar.st = nullptr;
    if (args.one_launch) bar = xcd_barrier_post(F.ctl + CW_BAR, F.MISC + 8, F.tid == 0);
    const int lo = args.ph_lo, hi = args.ph_hi;
#ifndef DUP_PHASE
#define DUP_PHASE -1
#endif
#define REPS(k) for (int rep_ = 0; rep_ < ((k) == DUP_PHASE ? 2 : 1); ++rep_)
#ifndef PH_MASK
#define PH_MASK 0x3fff
#endif
#define IN(k) (((PH_MASK >> (k)) & 1) && lo <= (k) && (k) < hi)
#define SEAM(k) do { if (IN(k) && IN((k) + 1)) xcd_barrier(bar, F.wave); } while (0)

    if (IN(0)) REPS(0) { RELAUNDER(); if (rep_) xcd_barrier(bar, F.wave); p0_prologue(F); } SEAM(0);
    if (IN(1)) REPS(1) { RELAUNDER(); if (rep_) xcd_barrier(bar, F.wave); norm_mod_rows<false>(F, F.vcu * NWAVES + F.wave, MT, F.G * NWAVES, INP(I_NMIX), 0, (bf16_t*)(F.ws + WS_H), nullptr, true); } SEAM(1);
    if (IN(2)) REPS(2) { RELAUNDER(); if (rep_) xcd_barrier(bar, F.wave); pg8::Gemm g{(const bf16_t*)(F.ws + WS_H), (const bf16_t*)(F.ws + WS_WIN), DM, INW, DM, INW / 256, (size_t)DM * INW * 2}; pg8::StaticOrder S; S.init(MT, INW, F.G, (int)blockIdx.x);
        pg8::EpiProj E{(bf16_t*)(F.ws + WS_P), INW, INP(I_QNA), INP(I_KNA), INP(I_QNB), INP(I_KNB), (const f32x4*)(F.ws + WS_CS), (LAS float*)(F.lds + RING_BYTES)};
        pg8::gemm_phase<pg8::EpiProj, pg8::StaticOrder, true>(F.lds, g, S, E, F.tid); }
    SEAM(3);
    if (IN(4)) REPS(4) { RELAUNDER(); if (rep_) xcd_barrier(bar, F.wave);
        const attn::bf16* P = (const attn::bf16*)(F.ws + WS_P);
#if P0_EXPERTS
#define XSIDE(st) NoSide{}
#else
#define XSIDE(st) XcvtSide{&F, (F.G == 256) ? (st) : (1 << 20)}
#endif
#ifndef NO_GQA
        for (int U = F.vcu; U < 256; U += F.G) { const int he = U >> 5, qb = U & 31; RELAUNDER();
#if GQA_DMA_BODY
            attn::attn_dma_body<4>(P + (size_t)(CTXL + qb * 256) * INW + C_AQ + he * 128, P + C_AK + (he >> 2) * 128, P + C_AV + (he >> 2) * 128,
                                   (float*)(F.ws + WS_OA) + (size_t)(qb * 256) * 1024 + he * 128, MT, F.lds, F.tid, XSIDE(0)); }
#else
            attn::attn_dense_body(P + (size_t)(CTXL + qb * 256) * INW + C_AQ + he * 128, P + C_AK + (he >> 2) * 128, P + C_AV + (he >> 2) * 128,
                                  (float*)(F.ws + WS_OA) + (size_t)(qb * 256) * 1024 + he * 128, MT, (char*)lds, F.tid); }
#endif
#endif
#ifndef NO_DIFF
        for (int U = F.vcu; U < 256; U += F.G) { const int hm = U >> 5, qb = U & 31, h = hm >> 1, m = hm & 1; RELAUNDER();
            attn::attn_dma_body<8>(P + (size_t)(CTXL + qb * 256) * INW + C_BQ + hm * 128, P + C_BK + hm * 128, P + C_BV + h * 256,
                                 (float*)(F.ws + (m ? WS_OB1 : WS_OB0)) + (size_t)(qb * 256) * 1024 + h * 256, MT, F.lds, F.tid, XSIDE(MT / 64)); }
#endif
#if !P0_EXPERTS
        if (F.G != 256) { RELAUNDER(); for (int J = F.vcu * NWAVES + F.wave; J < XJ_TOTAL; J += F.G * NWAVES) { const float* src; int ld; bf16_t* dst; float v[8];
            xjob_decode(F, J, F.lane, src, ld, dst); cvt_load8(v, src, ld); cvt_store8(v, dst); } }
#endif
    } SEAM(4);
    if (IN(5)) REPS(5) { RELAUNDER(); if (rep_) xcd_barrier(bar, F.wave); p5_combine(F); }
    SEAM(6);
    if (IN(7)) REPS(7) { RELAUNDER(); if (rep_) xcd_barrier(bar, F.wave); pg8::Gemm g{(const bf16_t*)(F.ws + WS_A2), (const bf16_t*)(F.ws + WS_WAB), DM, DM, DM, DM / 256, (size_t)DM * DM * 2}; pg8::StaticOrder S; S.init(SEQ, DM, F.G, (int)blockIdx.x);
        pg8::EpiGate2Bf16 E{(bf16_t*)(F.ws + WS_Y), DM, (const bf16_t*)(F.ws + WS_P), INW, CTXL, C_GA, C_GB};
        pg8::gemm_phase<pg8::EpiGate2Bf16, pg8::StaticOrder, false>(F.lds, g, S, E, F.tid); } SEAM(7);
    if (IN(8)) REPS(8) { RELAUNDER(); if (rep_) xcd_barrier(bar, F.wave); pg8::Gemm g{(const bf16_t*)(F.ws + WS_Y), (const bf16_t*)(F.ws + WS_WO), DM, DM, DM, DM / 256, (size_t)DM * DM * 2}; pg8::StaticOrder S; S.init(SEQ, DM, F.G, (int)blockIdx.x);
        pg8::EpiResidF32 E{(float*)(F.ws + WS_X1), INP(I_X), DM, (const float*)(F.ws + WS_MOD) + 2 * DM};
        pg8::gemm_phase<pg8::EpiResidF32, pg8::StaticOrder, false>(F.lds, g, S, E, F.tid); }
    SEAM(9);
    if (IN(10)) REPS(10) { RELAUNDER(); if (rep_) xcd_barrier(bar, F.wave); p10_router(F); } SEAM(10);
    if (IN(11)) REPS(11) { RELAUNDER(); if (rep_) xcd_barrier(bar, F.wave); moe_tables(F);
        const LAS int* tab = (const LAS int*)(F.lds + TAB_OFF);
        pg8::Gemm g{(const bf16_t*)(F.ws + WS_H2HI), (const bf16_t*)(F.ws + WS_WGU), DM, NP_GU, DM, 4, GU_BYTES};
        pg8::MoeOrder S{tab, tab + 65, (const int*)(F.ws + WS_LIST), F.G, F.vcu, 4, __builtin_amdgcn_readfirstlane(tab[65 + 65]) * 4, true};
        pg8::EpiSwiglu E{(bf16_t*)(F.ws + WS_ACT), FE};
        pg8::gemm_phase<pg8::EpiSwiglu, pg8::MoeOrder, true>(F.lds, g, S, E, F.tid); } SEAM(11);
    if (IN(12)) REPS(12) { RELAUNDER(); if (rep_) xcd_barrier(bar, F.wave); moe_tables(F);
        const LAS int* tab = (const LAS int*)(F.lds + TAB_OFF);
        pg8::Gemm g{(const bf16_t*)(F.ws + WS_ACT), (const bf16_t*)(F.ws + WS_WD), FE, NP_D, FE, 8, D_BYTES};
        pg8::MoeOrder S{tab, tab + 65, (const int*)(F.ws + WS_LIST), F.G, F.vcu, 8, __builtin_amdgcn_readfirstlane(tab[65 + 65]) * 8, false};
        pg8::EpiFp8 E{(unsigned char*)(F.ws + WS_YROWS), DM};
        pg8::gemm_phase<pg8::EpiFp8, pg8::MoeOrder, true>(F.lds, g, S, E, F.tid); } SEAM(12);
    if (IN(13)) REPS(13) { RELAUNDER(); if (rep_) xcd_barrier(bar, F.wave); moe_tables(F); p13_final(F); }
#undef IN
#undef SEAM
}

extern "C" void kernel_launch(void* const* d_in, const int* in_sizes, int n_in, void* d_out, int out_size, void* d_ws, size_t ws_size, hipStream_t stream) {
    static int grid = 0;
    if (grid == 0) {
        if (n_in != 29 || in_sizes[0] != SEQ * DM || out_size != SEQ * DM || ws_size < WS_END) {
            fprintf(stderr, "kernel_launch: shape/workspace mismatch: n_in %d in0 %d out %d ws %zu (need %zu)\n", n_in, n_in > 0 ? in_sizes[0] : -1, out_size, ws_size, (size_t)WS_END); grid = -1; return; }
        int dev = 0, cus = 0, per_cu = 0;
        if (hipGetDevice(&dev) != hipSuccess || hipDeviceGetAttribute(&cus, hipDeviceAttributeMultiprocessorCount, dev) != hipSuccess) { grid = -1; return; }
        if (hipFuncSetAttribute((const void*)mk_fwd, hipFuncAttributeMaxDynamicSharedMemorySize, LDS_BYTES) != hipSuccess) { fprintf(stderr, "kernel_launch: hipFuncSetAttribute failed\n"); grid = -1; return; }
        if (hipOccupancyMaxActiveBlocksPerMultiprocessor(&per_cu, (const void*)mk_fwd, NTHREADS, LDS_BYTES) != hipSuccess || per_cu < 1)
            fprintf(stderr, "kernel_launch: occupancy query reports %d\n", per_cu);
        (void)hipGetLastError();
        grid = cus;
    }
    if (grid < 0) return;
    if (hipMemsetAsync((char*)d_ws + WS_CTL, 0, CTL_ZERO_BYTES, stream) != hipSuccess) return;
    Args a{};
    for (int i = 0; i < 29; ++i) a.in[i] = (const float*)d_in[i];
    a.out = (float*)d_out; a.ws = (unsigned char*)d_ws; a.pad = 0;
#if MK_ONE_LAUNCH
    a.ph_lo = 0; a.ph_hi = N_PHASES; a.one_launch = 1;
    hipLaunchKernelGGL(mk_fwd, dim3(grid), dim3(NTHREADS), LDS_BYTES, stream, a);
#else
    for (int p = 0; p < N_PHASES; ++p) { a.ph_lo = p; a.ph_hi = p + 1; a.one_launch = 0;
        for (int rep = 0; rep < (((HOST_DUP_MASK >> p) & 1) ? 2 : 1); ++rep)
        hipLaunchKernelGGL(mk_fwd, dim3(grid), dim3(NTHREADS), LDS_BYTES, stream, a); }
#endif
    const hipError_t le = hipPeekAtLastError();
    if (le != hipSuccess) fprintf(stderr, "kernel_launch: launch failed: %s\n", hipGetErrorName(le));
}
```
